# Optimizing an MI355X kernel written in HIP

```python
import math
import jax, jax.numpy as jnp
from jax import lax
import numpy as np

D_MODEL = 1024
BATCH = 32
SEQ = 256
DEPTH = 2
DEC_BATCH = 2
DEC_SEQ = 4096
PAST_LEN = 256

GRID_W = 64
N_GROUPS = 4
GROUP_W = D_MODEL // N_GROUPS
D_MIX = N_GROUPS * GROUP_W
HEAD_DIM = 64
N_HEADS_GROUP = GROUP_W // HEAD_DIM
N_SEGMENTS = 10
W_IN_COLS = N_SEGMENTS * GROUP_W
CONV_K = 31
NA_WIN_R = 8
NA_WIN_C = 16
DIFF_SUB = HEAD_DIM // 2
ROPE_BASE = 10000.0
CHUNK = 128
Q_BLOCK = 128
PEER_HEADS = 8
PEER_NKEYS = 128
PEER_EXPERTS = PEER_NKEYS * PEER_NKEYS
PEER_DKEY = 256
PEER_TOPK = 16
TOKEN_BLOCK = 128
EPS = 1e-6
NEG = -1e30

kernel_name = 'hybrid_conv_natten_diffattn_gmlp_peer_step'


def rms_norm(x, g):
    xf = x.astype(jnp.float32)
    y = xf * lax.rsqrt(jnp.mean(xf * xf, axis=-1, keepdims=True) + EPS)
    return (y * g.astype(jnp.float32)).astype(x.dtype)


def layer_norm(x, g, b):
    xf = x.astype(jnp.float32)
    mu = jnp.mean(xf, axis=-1, keepdims=True)
    xc = xf - mu
    y = xc * lax.rsqrt(jnp.mean(xc * xc, axis=-1, keepdims=True) + EPS)
    return (y * g.astype(jnp.float32) + b.astype(jnp.float32)).astype(x.dtype)


def adaln(cond, w_mod, b_mod):
    m = jax.nn.silu(cond) @ w_mod + b_mod
    return tuple(jnp.split(m[:, None, :], 6, axis=-1))


def split_heads(x):
    B, L, _ = x.shape
    return x.reshape(B, L, N_HEADS_GROUP, HEAD_DIM).transpose(0, 2, 1, 3)


def merge_heads(x):
    B, H, L, d = x.shape
    return x.transpose(0, 2, 1, 3).reshape(B, L, H * d)


def rope_1d(x, pos):
    half = x.shape[-1] // 2
    inv = ROPE_BASE ** (-jnp.arange(half, dtype=jnp.float32) / half)
    ang = pos[:, None] * inv[None, :]
    cos = jnp.cos(ang).astype(x.dtype)
    sin = jnp.sin(ang).astype(x.dtype)
    x1, x2 = x[..., :half], x[..., half:]
    return jnp.concatenate([x1 * cos - x2 * sin, x1 * sin + x2 * cos], axis=-1)


def axial_rope(x):
    t = jnp.arange(x.shape[-2])
    rows = (t // GRID_W).astype(jnp.float32)
    cols = (t % GRID_W).astype(jnp.float32)
    h = x.shape[-1] // 2
    return jnp.concatenate([rope_1d(x[..., :h], rows), rope_1d(x[..., h:], cols)], axis=-1)


def sweep_queries(fn, *qs):
    B, H, L, _ = qs[0].shape
    nb = L // Q_BLOCK
    blocks = tuple(q.reshape(B, H, nb, Q_BLOCK, q.shape[-1]).transpose(2, 0, 1, 3, 4) for q in qs)
    out = lax.map(lambda qb: fn(*qb), blocks)
    return out.transpose(1, 2, 0, 3, 4).reshape(B, H, L, out.shape[-1])


def softmax_attend(q, k, v):
    scale = q.shape[-1] ** -0.5
    def blk(qb):
        s = jnp.einsum('bhqd,bhkd->bhqk', qb, k).astype(jnp.float32) * scale
        p = jax.nn.softmax(s, axis=-1)
        return jnp.einsum('bhqk,bhkd->bhqd', p.astype(v.dtype), v)
    return sweep_queries(blk, q)


def diff_attend(q1, q2, k1, k2, v, lam):
    scale = DIFF_SUB ** -0.5
    def blk(q1b, q2b):
        s1 = jnp.einsum('bhqd,bhkd->bhqk', q1b, k1).astype(jnp.float32) * scale
        s2 = jnp.einsum('bhqd,bhkd->bhqk', q2b, k2).astype(jnp.float32) * scale
        a = jax.nn.softmax(s1, axis=-1) - lam * jax.nn.softmax(s2, axis=-1)
        return jnp.einsum('bhqk,bhkd->bhqd', a.astype(v.dtype), v)
    return sweep_queries(blk, q1, q2)


def neighbourhood_attend(q, k, v, ck, cv, rel_bias):
    B, H, S, d = q.shape
    rows = S // GRID_W
    wr = min(NA_WIN_R, rows)
    r = jnp.arange(rows)
    r0 = jnp.clip(r - wr // 2, 0, rows - wr)
    row_idx = r0[:, None] + jnp.arange(wr)[None, :]
    dr = row_idx - r[:, None]
    c = jnp.arange(GRID_W)
    c0 = jnp.clip(c - NA_WIN_C // 2, 0, GRID_W - NA_WIN_C)
    in_win = (c[None, :] >= c0[:, None]) & (c[None, :] < c0[:, None] + NA_WIN_C)
    dc_idx = jnp.clip(c[None, :] - c[:, None] + NA_WIN_C - 1, 0, 2 * NA_WIN_C - 2)
    rb = rel_bias[:, dr + NA_WIN_R - 1]
    bias = jnp.take(rb, dc_idx, axis=-1).transpose(0, 1, 3, 2, 4)
    qg = q.reshape(B, H, rows, GRID_W, d)
    kg = k.reshape(B, H, rows, GRID_W, d)[:, :, row_idx]
    vg = v.reshape(B, H, rows, GRID_W, d)[:, :, row_idx]
    scale = d ** -0.5
    s_loc = jnp.einsum('bhrqd,bhrwkd->bhrqwk', qg, kg).astype(jnp.float32) * scale + bias[None].astype(jnp.float32)
    s_loc = jnp.where(in_win[:, None, :], s_loc, NEG)
    s_ctx = jnp.einsum('bhrqd,bhmd->bhrqm', qg, ck).astype(jnp.float32) * scale
    n_loc = wr * GRID_W
    s = jnp.concatenate([s_loc.reshape(B, H, rows, GRID_W, n_loc), s_ctx], axis=-1)
    p = jax.nn.softmax(s, axis=-1).astype(v.dtype)
    p_loc = p[..., :n_loc].reshape(B, H, rows, GRID_W, wr, GRID_W)
    o = (jnp.einsum('bhrqwk,bhrwkd->bhrqd', p_loc, vg)
         + jnp.einsum('bhrqm,bhmd->bhrqd', p[..., n_loc:], cv))
    return o.reshape(B, H, S, d)


def conv_module(a, gate, w, b, ln_g, ln_b):
    y = a * jax.nn.sigmoid(gate)
    y = lax.conv_general_dilated(y, w[:, None, :], window_strides=(1,), padding='SAME',
                                 dimension_numbers=('NWC', 'WIO', 'NWC'),
                                 feature_group_count=GROUP_W) + b
    return jax.nn.silu(layer_norm(y, ln_g, ln_b))


def chunk_gmlp(u, v, ln_g, ln_b, ws, bs):
    u = jax.nn.gelu(u)
    v = layer_norm(jax.nn.gelu(v), ln_g, ln_b)
    B, L, _ = v.shape
    vg = v.reshape(B, L // CHUNK, CHUNK, N_HEADS_GROUP, GROUP_W // N_HEADS_GROUP)
    s = jnp.einsum('gij,bnjgc->bnigc', ws, vg) + bs.T[None, None, :, :, None]
    return u * s.reshape(B, L, GROUP_W)


def peer_ffn(h, wq, sub_keys, pu, pv):
    B, L, D = h.shape
    hb = h.reshape((B * L) // TOKEN_BLOCK, TOKEN_BLOCK, D)
    def blk(xb):
        q = (xb @ wq).reshape(TOKEN_BLOCK, PEER_HEADS, 2, PEER_DKEY // 2)
        s = jnp.einsum('thpk,pnk->thpn', q, sub_keys).astype(jnp.float32)
        sv, si = lax.top_k(s, PEER_TOPK)
        cand_s = (sv[:, :, 0, :, None] + sv[:, :, 1, None, :]).reshape(TOKEN_BLOCK, PEER_HEADS, PEER_TOPK * PEER_TOPK)
        cand_i = (si[:, :, 0, :, None] * PEER_NKEYS + si[:, :, 1, None, :]).reshape(TOKEN_BLOCK, PEER_HEADS, PEER_TOPK * PEER_TOPK)
        top_s, pos = lax.top_k(cand_s, PEER_TOPK)
        eidx = jnp.take_along_axis(cand_i, pos, axis=-1)
        g = jax.nn.softmax(top_s, axis=-1)
        a = jnp.einsum('thkd,td->thk', pu[eidx], xb)
        w = (jax.nn.gelu(a.astype(jnp.float32)) * g).astype(xb.dtype)
        return jnp.einsum('thk,thkd->td', w, pv[eidx])
    return lax.map(blk, hb).reshape(B, L, D)


def trunk_layer(x, mod, p, lam_init, ctx_kv=None):
    latent = ctx_kv is not None
    B, L, _ = x.shape
    sh1, sc1, g1, sh2, sc2, g2 = mod
    h = rms_norm(x, p['norm1']) * (1 + sc1) + sh1
    parts = jnp.split(h @ p['w_in'], N_SEGMENTS, axis=-1)
    conv_o = conv_module(parts[0], parts[1], p['conv_w'], p['conv_b'], p['conv_ln_g'], p['conv_ln_b'])
    nq = rms_norm(split_heads(parts[2]), p['na_qn'])
    nk = rms_norm(split_heads(parts[3]), p['na_kn'])
    nv = split_heads(parts[4])
    if latent:
        na_o = neighbourhood_attend(nq, nk, nv, ctx_kv[0], ctx_kv[1], p['na_bias'])
    else:
        na_o = softmax_attend(nq, nk, nv)
    sub = (B, N_HEADS_GROUP, L, 2, DIFF_SUB)
    dq = rms_norm(split_heads(parts[5]).reshape(sub), p['diff_qn'])
    dk = rms_norm(split_heads(parts[6]).reshape(sub), p['diff_kn'])
    dv = split_heads(parts[7])
    dq1, dq2, dk1, dk2 = dq[..., 0, :], dq[..., 1, :], dk[..., 0, :], dk[..., 1, :]
    if latent:
        ck, cv = ctx_kv[2], ctx_kv[3]
        dq1, dq2 = axial_rope(dq1), axial_rope(dq2)
        dk1 = jnp.concatenate([axial_rope(dk1), ck[..., :DIFF_SUB]], axis=2)
        dk2 = jnp.concatenate([axial_rope(dk2), ck[..., DIFF_SUB:]], axis=2)
        dvals = jnp.concatenate([dv, cv], axis=2)
    else:
        dvals = dv
    dl = p['diff_lambda'].astype(jnp.float32)
    lam = jnp.exp(jnp.sum(dl[0] * dl[1])) - jnp.exp(jnp.sum(dl[2] * dl[3])) + lam_init
    diff_o = diff_attend(dq1, dq2, dk1, dk2, dvals, lam)
    diff_o = rms_norm(diff_o, p['diff_subln']) * (1.0 - lam_init)
    gm_o = chunk_gmlp(parts[8], parts[9], p['gmlp_ln_g'], p['gmlp_ln_b'], p['gmlp_ws'], p['gmlp_bs'])
    mixed = jnp.concatenate([conv_o, merge_heads(na_o), merge_heads(diff_o), gm_o], axis=-1) @ p['w_out']
    x = x + g1 * mixed
    h2 = rms_norm(x, p['norm2']) * (1 + sc2) + sh2
    x = x + g2 * peer_ffn(h2, p['peer_wq'], p['peer_sub_keys'], p['peer_u'], p['peer_v'])
    if latent:
        return x, None
    dk_flat = dk.reshape(B, N_HEADS_GROUP, L, HEAD_DIM)
    return x, (jnp.stack([nk, nv], axis=1), jnp.stack([dk_flat, dv], axis=1))


def setup_inputs(seed: int = 0) -> dict:
    key = jax.random.key(seed)
    ks = iter(jax.random.split(key, 40))
    def nrm(shape, s):
        return jax.random.normal(next(ks), shape, jnp.float32) * s
    cache_shape = (DEC_BATCH, DEPTH, 2, N_HEADS_GROUP, PAST_LEN, HEAD_DIM)
    return {
        'x_prompt': nrm((BATCH, SEQ, D_MODEL), 1.0),
        'x_sample': nrm((DEC_BATCH, DEC_SEQ, D_MODEL), 1.0),
        'cache_na_kv': nrm(cache_shape, 1.0),
        'cache_diff_kv': nrm(cache_shape, 1.0),
        'c': nrm((DEC_BATCH, D_MODEL), 1.0),
        'c_ctx': nrm((D_MODEL,), 1.0),
        'w_mod': nrm((DEPTH, D_MODEL, 6 * D_MODEL), 0.5 * D_MODEL ** -0.5),
        'b_mod': nrm((DEPTH, 6 * D_MODEL), 0.02),
        'norm1_g': 1.0 + nrm((DEPTH, D_MODEL), 0.1),
        'norm2_g': 1.0 + nrm((DEPTH, D_MODEL), 0.1),
        'w_in': nrm((DEPTH, D_MODEL, W_IN_COLS), D_MODEL ** -0.5),
        'conv_w': nrm((DEPTH, CONV_K, GROUP_W), CONV_K ** -0.5),
        'conv_b': nrm((DEPTH, GROUP_W), 0.02),
        'conv_ln_g': 1.0 + nrm((DEPTH, GROUP_W), 0.1),
        'conv_ln_b': nrm((DEPTH, GROUP_W), 0.02),
        'na_qn_g': 1.0 + nrm((DEPTH, HEAD_DIM), 0.1),
        'na_kn_g': 1.0 + nrm((DEPTH, HEAD_DIM), 0.1),
        'na_rel_bias': nrm((DEPTH, N_HEADS_GROUP, 2 * NA_WIN_R - 1, 2 * NA_WIN_C - 1), 0.1),
        'diff_qn_g': 1.0 + nrm((DEPTH, DIFF_SUB), 0.1),
        'diff_kn_g': 1.0 + nrm((DEPTH, DIFF_SUB), 0.1),
        'diff_lambda': nrm((DEPTH, 4, DIFF_SUB), 0.1),
        'diff_subln_g': 1.0 + nrm((DEPTH, HEAD_DIM), 0.1),
        'gmlp_ln_g': 1.0 + nrm((DEPTH, GROUP_W), 0.1),
        'gmlp_ln_b': nrm((DEPTH, GROUP_W), 0.02),
        'gmlp_ws': nrm((DEPTH, N_HEADS_GROUP, CHUNK, CHUNK), CHUNK ** -0.5),
        'gmlp_bs': 1.0 + nrm((DEPTH, N_HEADS_GROUP, CHUNK), 0.1),
        'w_out': nrm((DEPTH, D_MIX, D_MODEL), D_MIX ** -0.5),
        'peer_wq': nrm((DEPTH, D_MODEL, PEER_HEADS * PEER_DKEY), D_MODEL ** -0.5),
        'peer_sub_keys': nrm((DEPTH, 2, PEER_NKEYS, PEER_DKEY // 2), (PEER_DKEY // 2) ** -0.5),
        'peer_u': nrm((DEPTH, PEER_EXPERTS, D_MODEL), D_MODEL ** -0.5),
        'peer_v': nrm((DEPTH, PEER_EXPERTS, D_MODEL), 0.25),
    }


def reference(x_prompt, x_sample, cache_na_kv, cache_diff_kv, c, c_ctx, w_mod, b_mod, norm1_g, norm2_g,
              w_in, conv_w, conv_b, conv_ln_g, conv_ln_b, na_qn_g, na_kn_g, na_rel_bias, diff_qn_g,
              diff_kn_g, diff_lambda, diff_subln_g, gmlp_ln_g, gmlp_ln_b, gmlp_ws, gmlp_bs, w_out,
              peer_wq, peer_sub_keys, peer_u, peer_v):
    y_prompt, y_sample = x_prompt, x_sample
    na_states, diff_states = [], []
    for l in range(DEPTH):
        p = {
            'norm1': norm1_g[l], 'norm2': norm2_g[l], 'w_in': w_in[l],
            'conv_w': conv_w[l], 'conv_b': conv_b[l], 'conv_ln_g': conv_ln_g[l], 'conv_ln_b': conv_ln_b[l],
            'na_qn': na_qn_g[l], 'na_kn': na_kn_g[l], 'na_bias': na_rel_bias[l],
            'diff_qn': diff_qn_g[l], 'diff_kn': diff_kn_g[l], 'diff_lambda': diff_lambda[l],
            'diff_subln': diff_subln_g[l],
            'gmlp_ln_g': gmlp_ln_g[l], 'gmlp_ln_b': gmlp_ln_b[l], 'gmlp_ws': gmlp_ws[l], 'gmlp_bs': gmlp_bs[l],
            'w_out': w_out[l], 'peer_wq': peer_wq[l], 'peer_sub_keys': peer_sub_keys[l],
            'peer_u': peer_u[l], 'peer_v': peer_v[l],
        }
        lam_init = 0.8 - 0.6 * math.exp(-0.3 * l)
        mod_ctx = adaln(c_ctx[None, :], w_mod[l], b_mod[l])
        y_prompt, (na_kv, diff_kv) = trunk_layer(y_prompt, mod_ctx, p, lam_init)
        na_states.append(na_kv)
        diff_states.append(diff_kv)
        mod_lat = adaln(c, w_mod[l], b_mod[l])
        ctx = (cache_na_kv[:, l, 0], cache_na_kv[:, l, 1], cache_diff_kv[:, l, 0], cache_diff_kv[:, l, 1])
        y_sample, _ = trunk_layer(y_sample, mod_lat, p, lam_init, ctx)
    new_na_kv = jnp.stack(na_states, axis=1)
    new_diff_kv = jnp.stack(diff_states, axis=1)
    return (y_prompt, y_sample, new_na_kv, new_diff_kv)
```

```cpp
#include <hip/hip_runtime.h>
#include <hip/hip_cooperative_groups.h>
#include <cstdio>
namespace cg = cooperative_groups;

#define DI __device__ __forceinline__
typedef unsigned short u16;
typedef unsigned int u32;
using bf16x8 = __attribute__((ext_vector_type(8))) short;
using f32x16 = __attribute__((ext_vector_type(16))) float;
using u32x4 = __attribute__((ext_vector_type(4))) unsigned;
using u32x2 = __attribute__((ext_vector_type(2))) unsigned;
#define MFMA32(a, b, c) __builtin_amdgcn_mfma_f32_32x32x16_bf16((a), (b), (c), 0, 0, 0)

#ifndef PROBE_EPI4
#define PROBE_EPI4 1
#endif
#ifndef PROBE_EPI2
#define PROBE_EPI2 1
#endif
#ifndef EXTRA_SYNCS
#define EXTRA_SYNCS 0
#endif
#ifndef DUP_PHASE
#define DUP_PHASE -1
#endif
#ifndef MIXMASK
#define MIXMASK 63
#endif
#ifndef PH_END
#define PH_END 15
#endif
#ifndef COOP
#define COOP 1
#endif

constexpr int T = 16384, TP = 8192;
constexpr float EPS = 1e-6f;
constexpr int NPHASE = 15;
constexpr int SMEM_BYTES = 74240;

constexpr size_t OFF_WTIN = 0;
constexpr size_t OFF_WTOUT = OFF_WTIN + 10485760;
constexpr size_t OFF_WTQ = OFF_WTOUT + 4194304;
constexpr size_t OFF_SUBK = OFF_WTQ + 8388608;
constexpr size_t OFF_GWS = OFF_SUBK + 131072;
constexpr size_t OFF_PU = OFF_GWS + 262144;
constexpr size_t OFF_PV = OFF_PU + 67108864;
constexpr size_t OFF_MOD = OFF_PV + 67108864;
constexpr size_t OFF_ROPE = OFF_MOD + 147456;
constexpr size_t OFF_CKNA = OFF_ROPE + 4096;
constexpr size_t OFF_CVNA = OFF_CKNA + 524288;
constexpr size_t OFF_CKD = OFF_CVNA + 524288;
constexpr size_t OFF_CVD = OFF_CKD + 524288;
constexpr size_t OFF_CTR = OFF_CVD + 524288;
constexpr size_t OFF_H = OFF_CTR + 256;
constexpr size_t OFF_CONVA = OFF_H + 33554432;
constexpr size_t OFF_CONVG = OFF_CONVA + 8388608;
constexpr size_t OFF_QNA = OFF_CONVG + 8388608;
constexpr size_t OFF_KNA = OFF_QNA + 8388608;
constexpr size_t OFF_VNAT = OFF_KNA + 8388608;
constexpr size_t OFF_QD = OFF_VNAT + 8388608;
constexpr size_t OFF_KD = OFF_QD + 8388608;
constexpr size_t OFF_VDT = OFF_KD + 8388608;
constexpr size_t OFF_GU = OFF_VDT + 8388608;
constexpr size_t OFF_GV = OFF_GU + 8388608;
constexpr size_t OFF_MIX = OFF_GV + 8388608;
constexpr size_t OFF_XMID = OFF_MIX + 33554432;
constexpr size_t OFF_EIDX = OFF_XMID + 67108864;
constexpr size_t OFF_GATE = OFF_EIDX + 8388608;
constexpr size_t OFF_LTMP = OFF_GATE + 8388608;
constexpr size_t OFF_SU = OFF_LTMP + 16777216;
constexpr size_t OFF_SV = OFF_SU + 131072;
constexpr size_t OFF_BAR = OFF_SV + 131072;
constexpr size_t OFF_WQB = OFF_BAR + 16384;
constexpr size_t WS_END = OFF_WQB + 8388608;

constexpr size_t OUT_NAKV = 16777216;
constexpr size_t OUT_DKV = 25165824;

struct Params {
  const float* in[31];
  float* out;
  unsigned char* ws;
};

DI int tid_opaque() { int t = threadIdx.x; asm volatile("" : "+v"(t)); return t; }
typedef __bf16 bf16x2_t __attribute__((ext_vector_type(2)));
typedef float f32x2_t __attribute__((ext_vector_type(2)));
DI u32 f2bf(float x) { u32 u = __float_as_uint(x); u += 0x7fffu + ((u >> 16) & 1u); return u >> 16; }
DI u32 pack2(float a, float b) { f32x2_t v = {a, b}; return __builtin_bit_cast(u32, __builtin_convertvector(v, bf16x2_t)); }
DI float bf_lo(u32 p) { return __uint_as_float(p << 16); }
DI float bf_hi(u32 p) { return __uint_as_float(p & 0xffff0000u); }
DI float bf1(u16 v) { return __uint_as_float(((u32)v) << 16); }
DI float sigmoid_f(float x) { return __builtin_amdgcn_rcpf(1.f + __expf(-x)); }
DI float gelu_f(float x) {
  float u = 0.7978845608028654f * (x + 0.044715f * x * x * x);
  float e = __expf(2.f * u);
  float t = 1.f - 2.f * __builtin_amdgcn_rcpf(e + 1.f);
  return 0.5f * x * (1.f + t);
}
DI int crow(int i, int h) { return (i & 3) + 8 * (i >> 2) + 4 * h; }
DI int clampi(int v, int lo, int hi) { return v < lo ? lo : (v > hi ? hi : v); }
DI void st8(u16* dst, const float* v) {
  u32x4 o; o[0] = pack2(v[0], v[1]); o[1] = pack2(v[2], v[3]); o[2] = pack2(v[4], v[5]); o[3] = pack2(v[6], v[7]);
  *(u32x4*)dst = o;
}
DI float swz_xor(float v, int d) {
  int r;
  if (d == 1) r = __builtin_amdgcn_ds_swizzle(__float_as_int(v), (1 << 10) | 0x1F);
  else if (d == 2) r = __builtin_amdgcn_ds_swizzle(__float_as_int(v), (2 << 10) | 0x1F);
  else if (d == 4) r = __builtin_amdgcn_ds_swizzle(__float_as_int(v), (4 << 10) | 0x1F);
  else if (d == 8) r = __builtin_amdgcn_ds_swizzle(__float_as_int(v), (8 << 10) | 0x1F);
  else r = __builtin_amdgcn_ds_swizzle(__float_as_int(v), (16 << 10) | 0x1F);
  return __int_as_float(r);
}
DI float wave_sum(float v) {
#pragma unroll
  for (int d = 32; d >= 1; d >>= 1) v += __shfl_xor(v, d);
  return v;
}
DI const float* xin_row(const Params& p, int l, int t) {
  if (l == 0) return t < TP ? p.in[0] + (size_t)t * 1024 : p.in[1] + (size_t)(t - TP) * 1024;
  return p.out + (size_t)t * 1024;
}
DI int mod_row(int t) { return t < TP ? 0 : 1 + ((t - TP) >> 12); }
template <typename Tp> DI Tp* wsp(const Params& p, size_t off) { return (Tp*)(p.ws + off); }

DI void transpose_tile(const float* src, u16* dst, int K, int N, int k0, int n0, float* t) {
  const int tid = tid_opaque();
#pragma unroll
  for (int i = 0; i < 16; ++i) {
    int k = i * 4 + (tid >> 6), n = tid & 63;
    t[k * 65 + n] = src[(size_t)(k0 + k) * N + n0 + n];
  }
  __syncthreads();
  {
    int n = tid >> 2, kq = (tid & 3) * 16;
    float v[16];
#pragma unroll
    for (int j = 0; j < 16; ++j) v[j] = t[(kq + j) * 65 + n];
    u16* d = dst + (size_t)(n0 + n) * K + k0 + kq;
    st8(d, v); st8(d + 8, v + 8);
  }
  __syncthreads();
}

DI void convert_range(const float* src, u16* dst, size_t n8) {
  size_t stride = (size_t)gridDim.x * 256;
  const int tid_ = tid_opaque();
  for (size_t i = (size_t)blockIdx.x * 256 + tid_; i < n8; i += stride) {
    float4 a = ((const float4*)src)[2 * i], b = ((const float4*)src)[2 * i + 1];
    u32x4 o; o[0] = pack2(a.x, a.y); o[1] = pack2(a.z, a.w); o[2] = pack2(b.x, b.y); o[3] = pack2(b.z, b.w);
    ((u32x4*)dst)[i] = o;
  }
}

DI void quant_rows64(const float* src, unsigned char* dst, float* rscale, int row0) {
  const int tid_ = tid_opaque();
  const int lane = tid_ & 63;
  const int nrows = row0 + 64, nw = 1;
#pragma nounroll
  for (int rb = row0 + (tid_ >> 6) * 16; rb < row0 + (tid_ >> 6) * 16 + 16; rb += 2) {
    float4 v[2][4];
    float am[2];
#pragma unroll
    for (int u = 0; u < 2; ++u) {
      const int row = rb + u * nw;
      const float* s = src + (size_t)(row < nrows ? row : rb) * 1024 + lane * 16;
      float a = 0.f;
#pragma unroll
      for (int i = 0; i < 4; ++i) {
        v[u][i] = *(const float4*)(s + i * 4);
        a = fmaxf(a, fmaxf(fmaxf(fabsf(v[u][i].x), fabsf(v[u][i].y)), fmaxf(fabsf(v[u][i].z), fabsf(v[u][i].w))));
      }
      am[u] = a;
    }
#pragma unroll
    for (int u = 0; u < 2; ++u) {
#pragma unroll
      for (int d = 32; d >= 1; d >>= 1) am[u] = fmaxf(am[u], __shfl_xor(am[u], d));
    }
#pragma unroll
    for (int u = 0; u < 2; ++u) {
      const int row = rb + u * nw;
      if (row < nrows) {
        const float sc = am[u] > 0.f ? 6.f / am[u] : 0.f;
        u32x2 o;
#pragma unroll
        for (int hh = 0; hh < 2; ++hh) {
          u32 pk = 0u;
          pk = __builtin_amdgcn_cvt_scalef32_pk_fp4_f32(pk, v[u][2 * hh].x * sc, v[u][2 * hh].y * sc, 1.0f, 0);
          pk = __builtin_amdgcn_cvt_scalef32_pk_fp4_f32(pk, v[u][2 * hh].z * sc, v[u][2 * hh].w * sc, 1.0f, 1);
          pk = __builtin_amdgcn_cvt_scalef32_pk_fp4_f32(pk, v[u][2 * hh + 1].x * sc, v[u][2 * hh + 1].y * sc, 1.0f, 2);
          pk = __builtin_amdgcn_cvt_scalef32_pk_fp4_f32(pk, v[u][2 * hh + 1].z * sc, v[u][2 * hh + 1].w * sc, 1.0f, 3);
          o[hh] = pk;
        }
        *(u32x2*)(dst + (size_t)row * 512 + lane * 8) = o;
        if (lane == 0) rscale[row] = am[u] * (1.f / 6.f);
      }
    }
  }
}

DI void transpose_item(const Params& p, int item, float* sf) {
  const float* src; u16* dst; int N, it;
  if (item < 1280) { it = item; N = 2560; src = p.in[10]; dst = wsp<u16>(p, OFF_WTIN); }
  else if (item < 1792) { it = item - 1280; N = 1024; src = p.in[26]; dst = wsp<u16>(p, OFF_WTOUT); }
  else { it = item - 1792; N = 2048; src = p.in[27]; dst = wsp<u16>(p, OFF_WTQ); }
  int per_layer = 16 * (N / 64);
  int l = it / per_layer, r = it % per_layer;
  int kt = r / (N / 64), nt = r % (N / 64);
  transpose_tile(src + (size_t)l * 1024 * N, dst + (size_t)l * 1024 * N, 1024, N, kt * 64, nt * 64, sf);
}

DI void phase0(const Params& p, unsigned char* smem) {
  const int tid = tid_opaque(), bid = blockIdx.x, nb = gridDim.x;
  float* sf = (float*)smem;
  if (bid == 0 && tid < 8) wsp<int>(p, OFF_CTR)[tid] = 0;
  for (int i = tid; i < 3072; i += 256) {
    int r = i >> 10, k = i & 1023;
    float c = (r == 0) ? p.in[5][k] : p.in[4][(r - 1) * 1024 + k];
    sf[i] = c * sigmoid_f(c);
  }
  __syncthreads();
  for (int item = bid; item < 384; item += nb) {
    const int l = item / 192, n0 = (item % 192) * 32, col = tid & 31, kg = tid >> 5;
    float a0 = 0.f, a1 = 0.f, a2 = 0.f;
    const float* wm = p.in[6] + (size_t)l * 1024 * 6144 + n0 + col;
    for (int k0 = kg * 128; k0 < kg * 128 + 128; k0 += 16) {
      float w[16];
#pragma unroll
      for (int j = 0; j < 16; ++j) w[j] = wm[(size_t)(k0 + j) * 6144];
#pragma unroll
      for (int j = 0; j < 16; ++j) { a0 += sf[k0 + j] * w[j]; a1 += sf[1024 + k0 + j] * w[j]; a2 += sf[2048 + k0 + j] * w[j]; }
    }
    float* red = sf + 3072;
    red[(kg * 3 + 0) * 32 + col] = a0; red[(kg * 3 + 1) * 32 + col] = a1; red[(kg * 3 + 2) * 32 + col] = a2;
    __syncthreads();
    if (tid < 96) {
      int r = tid >> 5, c = tid & 31;
      float s = 0.f;
#pragma unroll
      for (int g = 0; g < 8; ++g) s += red[(g * 3 + r) * 32 + c];
      wsp<float>(p, OFF_MOD)[(size_t)(l * 3 + r) * 6144 + n0 + c] = s + p.in[7][l * 6144 + n0 + c];
    }
    __syncthreads();
  }
  __syncthreads();
  for (int item = bid; item < 640; item += nb) transpose_item(p, item, sf);
  convert_range(p.in[27], wsp<u16>(p, OFF_WQB), (size_t)2 * 1024 * 2048 / 8);
  convert_range(p.in[28], wsp<u16>(p, OFF_SUBK), (size_t)2 * 2 * 128 * 128 / 8);
  convert_range(p.in[24], wsp<u16>(p, OFF_GWS), (size_t)2 * 4 * 128 * 128 / 8);
  {
    size_t stride = (size_t)nb * 256;
    for (size_t i = (size_t)bid * 256 + tid; i < 262144; i += stride) {
      int d = i & 63, m = (i >> 6) & 255, bl_h = (int)(i >> 14);
      int blv = bl_h >> 2, hh = bl_h & 3;
      size_t sk = ((((size_t)blv * 2 + 0) * 4 + hh) * 256 + m) * 64 + d;
      size_t sv = ((((size_t)blv * 2 + 1) * 4 + hh) * 256 + m) * 64 + d;
      size_t dv = ((size_t)bl_h * 64 + d) * 256 + m;
      wsp<u16>(p, OFF_CKNA)[i] = (u16)f2bf(p.in[2][sk]);
      wsp<u16>(p, OFF_CVNA)[dv] = (u16)f2bf(p.in[2][sv]);
      wsp<u16>(p, OFF_CKD)[i] = (u16)f2bf(p.in[3][sk]);
      wsp<u16>(p, OFF_CVD)[dv] = (u16)f2bf(p.in[3][sv]);
    }
  }
  if (bid == (nb > 1 ? 1 : 0)) {
    for (int i = tid; i < 512; i += 256) {
      int pos = i >> 3, k = i & 7;
      const float invs[8] = {1.0f, 0.31622776601683794f, 0.1f, 0.031622776601683794f, 0.01f, 0.0031622776601683794f, 0.001f, 0.00031622776601683794f};
      float inv = invs[0];
#pragma unroll
      for (int q = 1; q < 8; ++q) inv = (k == q) ? invs[q] : inv;
      float ang = (float)pos * inv;
      float rev = ang * 0.15915494309189535f;
      rev = rev - floorf(rev);
      wsp<float>(p, OFF_ROPE)[i * 2 + 0] = __builtin_amdgcn_cosf(rev);
      wsp<float>(p, OFF_ROPE)[i * 2 + 1] = __builtin_amdgcn_sinf(rev);
    }
  }
}

DI void phase_norm(const Params& p, int l, int which) {
  const int tid = tid_opaque(), lane = tid & 63;
  const int gw = blockIdx.x * 4 + (tid >> 6), nw = gridDim.x * 4;
  const float* gam = p.in[which == 0 ? 8 : 9] + l * 1024;
  u16* H = wsp<u16>(p, OFF_H);
  for (int tb = gw; tb < T; tb += nw * 4) {
    float4 v[4][4];
    float ss[4];
#pragma unroll
    for (int u = 0; u < 4; ++u) {
      const int t = tb + u * nw;
      if (t < T) {
        const float* xr = (which == 0) ? xin_row(p, l, t) : wsp<float>(p, OFF_XMID) + (size_t)t * 1024;
#pragma unroll
        for (int i = 0; i < 4; ++i) v[u][i] = *(const float4*)(xr + i * 256 + lane * 4);
      } else {
#pragma unroll
        for (int i = 0; i < 4; ++i) v[u][i] = make_float4(0.f, 0.f, 0.f, 0.f);
      }
    }
#pragma unroll
    for (int u = 0; u < 4; ++u) {
      float s = 0.f;
#pragma unroll
      for (int i = 0; i < 4; ++i) s += v[u][i].x * v[u][i].x + v[u][i].y * v[u][i].y + v[u][i].z * v[u][i].z + v[u][i].w * v[u][i].w;
      ss[u] = wave_sum(s);
    }
#pragma unroll
    for (int u = 0; u < 4; ++u) {
      const int t = tb + u * nw;
      if (t < T) {
        const float* md = wsp<float>(p, OFF_MOD) + (size_t)(l * 3 + mod_row(t)) * 6144 + (which == 0 ? 0 : 3072);
        const float rs = rsqrtf(ss[u] * (1.f / 1024.f) + EPS);
#pragma unroll
        for (int i = 0; i < 4; ++i) {
          int n = i * 256 + lane * 4;
          float4 g = *(const float4*)(gam + n), sh = *(const float4*)(md + n), sc = *(const float4*)(md + 1024 + n);
          float o0 = v[u][i].x * rs * g.x * (1.f + sc.x) + sh.x;
          float o1 = v[u][i].y * rs * g.y * (1.f + sc.y) + sh.y;
          float o2 = v[u][i].z * rs * g.z * (1.f + sc.z) + sh.z;
          float o3 = v[u][i].w * rs * g.w * (1.f + sc.w) + sh.w;
          u32x2 o; o[0] = pack2(o0, o1); o[1] = pack2(o2, o3);
          *(u32x2*)(H + (size_t)t * 1024 + n) = o;
        }
      }
    }
  }
}

struct GemmPre { u32x4 ra[4], rb[4]; };
DI void gemm_prefetch(const int tid, const u16* A, const u16* Bt, int K, int m0, int n0, GemmPre& pre) {
  const int lrow = tid >> 3, lkc = (tid & 7) * 8;
  const u16* ag = A + (size_t)(m0 + lrow) * K + lkc;
  const u16* bg = Bt + (size_t)(n0 + lrow) * K + lkc;
#pragma unroll
  for (int i = 0; i < 4; ++i) { pre.ra[i] = *(const u32x4*)(ag + (size_t)i * 32 * K); pre.rb[i] = *(const u32x4*)(bg + (size_t)i * 32 * K); }
}
template <bool PRE = false>
DI void gemm_main(const int tid, const u16* A, const u16* Bt, int K, int m0, int n0, u16* sm, f32x16 (&acc)[2][2], int lda = 0, int ldb = 0, const GemmPre* pre = nullptr) {
  if (lda == 0) lda = K;
  if (ldb == 0) ldb = K;
  const int lane = tid & 63, w = tid >> 6, r = lane & 31, h = lane >> 5;
  const int wm = w >> 1, wn = w & 1;
  const int lrow = tid >> 3, lkc = (tid & 7) * 8;
  const u16* ag = A + (size_t)(m0 + lrow) * lda + lkc;
  const u16* bg = Bt + (size_t)(n0 + lrow) * ldb + lkc;
  u32x4 ra[4], rb[4];
#pragma unroll
  for (int a = 0; a < 2; ++a)
#pragma unroll
    for (int b = 0; b < 2; ++b)
#pragma unroll
      for (int i = 0; i < 16; ++i) acc[a][b][i] = 0.f;
  __syncthreads();
  if (PRE) {
#pragma unroll
    for (int i = 0; i < 4; ++i) { ra[i] = pre->ra[i]; rb[i] = pre->rb[i]; }
  } else {
#pragma unroll
    for (int i = 0; i < 4; ++i) { ra[i] = *(const u32x4*)(ag + (size_t)i * 32 * lda); rb[i] = *(const u32x4*)(bg + (size_t)i * 32 * ldb); }
  }
#pragma unroll
  for (int i = 0; i < 4; ++i) {
    *(u32x4*)(sm + (lrow + 32 * i) * 72 + lkc) = ra[i];
    *(u32x4*)(sm + 9216 + (lrow + 32 * i) * 72 + lkc) = rb[i];
  }
  __syncthreads();
  const int nk = K >> 6;
#pragma nounroll
  for (int kt = 0; kt < nk; ++kt) {
    const bool more = (kt + 1 < nk);
    if (more) {
#pragma unroll
      for (int i = 0; i < 4; ++i) {
        ra[i] = *(const u32x4*)(ag + (size_t)i * 32 * lda + (kt + 1) * 64);
        rb[i] = *(const u32x4*)(bg + (size_t)i * 32 * ldb + (kt + 1) * 64);
      }
    }
    const u16* sa = sm + (kt & 1) * 18432;
    const u16* sb = sa + 9216;
    {
      bf16x8 af[4][2], bfr[4][2];
#pragma unroll
      for (int ks = 0; ks < 4; ++ks) {
#pragma unroll
        for (int mt = 0; mt < 2; ++mt) af[ks][mt] = *(const bf16x8*)(sa + (wm * 64 + mt * 32 + r) * 72 + ks * 16 + 8 * h);
#pragma unroll
        for (int nt = 0; nt < 2; ++nt) bfr[ks][nt] = *(const bf16x8*)(sb + (wn * 64 + nt * 32 + r) * 72 + ks * 16 + 8 * h);
      }
      __builtin_amdgcn_sched_barrier(0);
#pragma unroll
      for (int ks = 0; ks < 4; ++ks)
#pragma unroll
        for (int mt = 0; mt < 2; ++mt)
#pragma unroll
          for (int nt = 0; nt < 2; ++nt) acc[mt][nt] = MFMA32(af[ks][mt], bfr[ks][nt], acc[mt][nt]);
      __builtin_amdgcn_sched_barrier(0);
    }
    if (more) {
      u16* da = sm + ((kt + 1) & 1) * 18432;
#pragma unroll
      for (int i = 0; i < 4; ++i) {
        *(u32x4*)(da + (lrow + 32 * i) * 72 + lkc) = ra[i];
        *(u32x4*)(da + 9216 + (lrow + 32 * i) * 72 + lkc) = rb[i];
      }
    }
    __syncthreads();
  }
}

template <int STRIDE = 129>
DI void acc_to_lds(const int tid, const f32x16 (&acc)[2][2], float* Ct) {
  const int lane = tid & 63, w = tid >> 6, r = lane & 31, h = lane >> 5;
  const int wm = w >> 1, wn = w & 1;
#pragma unroll
  for (int mt = 0; mt < 2; ++mt)
#pragma unroll
    for (int nt = 0; nt < 2; ++nt)
#pragma unroll
      for (int i = 0; i < 16; ++i) Ct[(wm * 64 + mt * 32 + crow(i, h)) * STRIDE + wn * 64 + nt * 32 + r] = acc[mt][nt][i];
}

DI void fusedwq_item(const Params& p, int item, unsigned char* smem) {
  const int tid = tid_opaque();
  const int l = item >> 7, hp = (item >> 3) & 15, dc = item & 7;
  const u16* A = wsp<u16>(p, OFF_SUBK) + (size_t)(l * 2 + (hp & 1)) * 128 * 128;
  const u16* Bt = wsp<u16>(p, OFF_WQB) + (size_t)l * 1024 * 2048 + hp * 128;
  f32x16 acc[2][2];
  gemm_main(tid, A, Bt, 128, 0, dc * 128, (u16*)smem, acc, 128, 2048);
  acc_to_lds<132>(tid, acc, (float*)smem);
  __syncthreads();
  const float* Ct = (const float*)smem;
  u16* dst = wsp<u16>(p, OFF_WTQ) + (size_t)l * 2048 * 1024 + (size_t)(hp * 128) * 1024 + dc * 128;
  const int c = (tid & 31) * 4;
#pragma unroll
  for (int it = 0; it < 16; ++it) {
    const int row = it * 8 + (tid >> 5);
    const float4 cv = *(const float4*)(Ct + row * 132 + c);
    u32x2 o; o[0] = pack2(cv.x, cv.y); o[1] = pack2(cv.z, cv.w);
    *(u32x2*)(dst + (size_t)row * 1024 + c) = o;
  }
  __syncthreads();
}

DI void epi_proj(const int tid, const Params& p, int l, int m0, int ntile, const float* Ct) {
  const int row = tid >> 1, ch = tid & 1;
  const int t = m0 + row;
  const int seg = ntile >> 1, half = ntile & 1;
  const float* cr = Ct + row * 129 + ch * 64;
  const int path = (t >= TP) ? 1 : 0;
  int b, pos, L;
  if (!path) { b = t >> 8; pos = t & 255; L = 256; } else { b = (t - TP) >> 12; pos = (t - TP) & 4095; L = 4096; }
  const int head = half * 2 + ch;
  const int cs = half * 128 + ch * 64;
  const size_t pbase = (size_t)path * 2097152;
  const size_t hm = pbase + ((size_t)(b * 4 + head) * L + pos) * 64;
  const size_t vt = pbase + ((size_t)(b * 4 + head) * 64) * L + pos;
  if (seg == 0 || seg == 1) {
    u16* dst = wsp<u16>(p, seg == 0 ? OFF_CONVA : OFF_CONVG) + (size_t)t * 256 + cs;
#pragma unroll
    for (int c8 = 0; c8 < 8; ++c8) { float v[8];
#pragma unroll
      for (int j = 0; j < 8; ++j) v[j] = cr[c8 * 8 + j];
      st8(dst + c8 * 8, v); }
  } else if (seg == 8 || seg == 9) {
    u16* dst = wsp<u16>(p, seg == 8 ? OFF_GU : OFF_GV) + (size_t)t * 256 + cs;
#pragma unroll
    for (int c8 = 0; c8 < 8; ++c8) { float v[8];
#pragma unroll
      for (int j = 0; j < 8; ++j) v[j] = gelu_f(cr[c8 * 8 + j]);
      st8(dst + c8 * 8, v); }
  } else if (seg == 2 || seg == 3) {
    float ss = 0.f;
#pragma unroll
    for (int j = 0; j < 64; ++j) ss += cr[j] * cr[j];
    const float rs = rsqrtf(ss * (1.f / 64.f) + EPS);
    const float* g = p.in[seg == 2 ? 15 : 16] + l * 64;
    u16* dst = wsp<u16>(p, seg == 2 ? OFF_QNA : OFF_KNA) + hm;
    float* okv = p.out + OUT_NAKV + (((((size_t)b * 2 + l) * 2 + 0) * 4 + head) * 256 + pos) * 64;
    const bool wkv = (seg == 3) && !path;
#pragma unroll
    for (int c8 = 0; c8 < 8; ++c8) { float v[8];
#pragma unroll
      for (int j = 0; j < 8; ++j) v[j] = cr[c8 * 8 + j] * rs * g[c8 * 8 + j];
      st8(dst + c8 * 8, v);
      if (wkv) { *(float4*)(okv + c8 * 8) = make_float4(v[0], v[1], v[2], v[3]); *(float4*)(okv + c8 * 8 + 4) = make_float4(v[4], v[5], v[6], v[7]); } }
  } else if (seg == 4 || seg == 7) {
    u16* dst = wsp<u16>(p, seg == 4 ? OFF_VNAT : OFF_VDT) + vt;
    float* okv = p.out + (seg == 4 ? OUT_NAKV : OUT_DKV) + (((((size_t)b * 2 + l) * 2 + 1) * 4 + head) * 256 + pos) * 64;
#pragma unroll
    for (int c8 = 0; c8 < 8; ++c8) { float v[8];
#pragma unroll
      for (int j = 0; j < 8; ++j) { v[j] = cr[c8 * 8 + j]; dst[(size_t)(c8 * 8 + j) * L] = (u16)f2bf(v[j]); }
      if (!path) { *(float4*)(okv + c8 * 8) = make_float4(v[0], v[1], v[2], v[3]); *(float4*)(okv + c8 * 8 + 4) = make_float4(v[4], v[5], v[6], v[7]); } }
  } else {
    const float* g = p.in[seg == 5 ? 18 : 19] + l * 32;
    u16* dst = wsp<u16>(p, seg == 5 ? OFF_QD : OFF_KD) + hm;
    float* okv = p.out + OUT_DKV + (((((size_t)b * 2 + l) * 2 + 0) * 4 + head) * 256 + pos) * 64;
    const bool wkv = (seg == 6) && !path;
    const float* rope = wsp<float>(p, OFF_ROPE);
    const int grow = pos >> 6, gcol = pos & 63;
#pragma unroll
    for (int sub = 0; sub < 2; ++sub) {
      float ss = 0.f;
#pragma unroll
      for (int j = 0; j < 32; ++j) ss += cr[sub * 32 + j] * cr[sub * 32 + j];
      const float rs = rsqrtf(ss * (1.f / 32.f) + EPS);
#pragma unroll
      for (int ps = 0; ps < 2; ++ps) {
        float x1[8], x2[8];
#pragma unroll
        for (int i = 0; i < 8; ++i) {
          x1[i] = cr[sub * 32 + ps * 16 + i] * rs * g[ps * 16 + i];
          x2[i] = cr[sub * 32 + ps * 16 + 8 + i] * rs * g[ps * 16 + 8 + i];
        }
        if (wkv) {
          float* o = okv + sub * 32 + ps * 16;
          *(float4*)(o) = make_float4(x1[0], x1[1], x1[2], x1[3]); *(float4*)(o + 4) = make_float4(x1[4], x1[5], x1[6], x1[7]);
          *(float4*)(o + 8) = make_float4(x2[0], x2[1], x2[2], x2[3]); *(float4*)(o + 12) = make_float4(x2[4], x2[5], x2[6], x2[7]);
        }
        if (path) {
          const float* rp = rope + (size_t)((ps == 0 ? grow : gcol) * 8) * 2;
#pragma unroll
          for (int i = 0; i < 8; ++i) {
            float c = rp[i * 2], s = rp[i * 2 + 1];
            float a1 = x1[i] * c - x2[i] * s, a2 = x1[i] * s + x2[i] * c;
            x1[i] = a1; x2[i] = a2;
          }
        }
        st8(dst + sub * 32 + ps * 16, x1);
        st8(dst + sub * 32 + ps * 16 + 8, x2);
      }
    }
  }
}

DI void phase_proj(const Params& p, int l, unsigned char* smem) {
  const int tid = tid_opaque();
  const u16* A = wsp<u16>(p, OFF_H);
  const u16* Bt = wsp<u16>(p, OFF_WTIN) + (size_t)l * 2560 * 1024;
  GemmPre pre;
  gemm_prefetch(tid, A, Bt, 1024, ((int)blockIdx.x / 20) * 128, ((int)blockIdx.x % 20) * 128, pre);
  for (int tile = blockIdx.x; tile < 128 * 20; tile += gridDim.x) {
    int mt = tile / 20, nt = tile % 20;
    f32x16 acc[2][2];
    gemm_main<true>(tid, A, Bt, 1024, mt * 128, nt * 128, (u16*)smem, acc, 0, 0, &pre);
    { const int nx = tile + gridDim.x; if (nx < 128 * 20) gemm_prefetch(tid, A, Bt, 1024, (nx / 20) * 128, (nx % 20) * 128, pre); }
    acc_to_lds(tid, acc, (float*)smem);
    __syncthreads();
    epi_proj(tid, p, l, mt * 128, nt, (const float*)smem);
#if PROBE_EPI2 > 1
    asm volatile("" ::: "memory");
    epi_proj(tid, p, l, mt * 128, nt, (const float*)smem);
#endif
  }
}

template <int MODE>
DI void attn_item(const Params& p, int l, int item, unsigned char* smem) {
  constexpr bool LAT = (MODE == 1 || MODE == 3);
  constexpr bool DIFF = (MODE >= 2);
  constexpr int NS = DIFF ? 2 : 1;
  const int tid = tid_opaque(), lane = tid & 63, w = tid >> 6, r = lane & 31, h = lane >> 5;
  u16* sK = (u16*)smem;
  u16* sV = sK + 64 * 72;
  float* sBias = (float*)(smem + 18432);
  u16* sO = (u16*)(smem + 18432 + 2048) + w * 32 * 72;
  int bh, L, path, qpos0;
  if (LAT) { bh = item >> 5; qpos0 = (item & 31) * 128; L = 4096; path = 1; }
  else { bh = item >> 1; qpos0 = (item & 1) * 128; L = 256; path = 0; }
  const int b = bh >> 2, hd = bh & 3;
  const size_t pbase = (size_t)path * 2097152;
  const u16* Qb = wsp<u16>(p, DIFF ? OFF_QD : OFF_QNA) + pbase + ((size_t)bh * L) * 64;
  const u16* Kb = wsp<u16>(p, DIFF ? OFF_KD : OFF_KNA) + pbase + ((size_t)bh * L) * 64;
  const u16* Vb = wsp<u16>(p, DIFF ? OFF_VDT : OFF_VNAT) + pbase + (size_t)bh * 64 * L;
  const u16* CK = wsp<u16>(p, DIFF ? OFF_CKD : OFF_CKNA) + ((size_t)((b * 2 + l) * 4 + hd) * 256) * 64;
  const u16* CV = wsp<u16>(p, DIFF ? OFF_CVD : OFF_CVNA) + ((size_t)((b * 2 + l) * 4 + hd) * 64) * 256;
  const int qpos = qpos0 + w * 32 + r;
  bf16x8 qf[4];
#pragma unroll
  for (int ks = 0; ks < 4; ++ks) qf[ks] = *(const bf16x8*)(Qb + (size_t)qpos * 64 + ks * 16 + 8 * h);
  const int qr = qpos >> 6, qc = qpos & 63;
  const int r0q = clampi(qr - 4, 0, 56), c0q = clampi(qc - 8, 0, 48);
  int rlo = 0, nloc = L / 64;
  if (MODE == 1) { int ra = qpos0 >> 6; rlo = clampi(ra - 4, 0, 56); int rhi = clampi(ra + 1 - 4, 0, 56) + 7; nloc = rhi - rlo + 1; }
  const int nctx = LAT ? 4 : 0;
  const int ntiles = nctx + nloc;
  const float scale = DIFF ? 0.17677669529663687f : 0.125f;
  if (MODE == 1) { for (int i = tid; i < 465; i += 256) sBias[i] = p.in[17][(size_t)(l * 4 + hd) * 465 + i]; }

  u32x4 rk[2], rv[2];
  auto gl = [&](int ti) {
    const u16* ks_; const u16* vs_; int vstr;
    if (LAT && ti < 4) { ks_ = CK + (size_t)ti * 64 * 64; vs_ = CV + ti * 64; vstr = 256; }
    else { int j = ti - nctx; int kp = (MODE == 1) ? (rlo + j) * 64 : j * 64; ks_ = Kb + (size_t)kp * 64; vs_ = Vb + kp; vstr = L; }
#pragma unroll
    for (int i = 0; i < 2; ++i) {
      int c = tid + 256 * i;
      rk[i] = *(const u32x4*)(ks_ + c * 8);
      rv[i] = *(const u32x4*)(vs_ + (size_t)(c >> 3) * vstr + (c & 7) * 8);
    }
  };
  f32x16 o[NS][2];
  float m_[NS], l_[NS];
#pragma unroll
  for (int s = 0; s < NS; ++s) { m_[s] = -1e30f; l_[s] = 0.f;
#pragma unroll
    for (int dt = 0; dt < 2; ++dt)
#pragma unroll
      for (int i = 0; i < 16; ++i) o[s][dt][i] = 0.f; }

  gl(0);
#pragma nounroll
  for (int ti = 0; ti < ntiles; ++ti) {
    __syncthreads();
#pragma unroll
    for (int i = 0; i < 2; ++i) {
      int c = tid + 256 * i;
      *(u32x4*)(sK + (c >> 3) * 72 + (c & 7) * 8) = rk[i];
      *(u32x4*)(sV + (c >> 3) * 72 + (c & 7) * 8) = rv[i];
    }
    __syncthreads();
    if (ti + 1 < ntiles) gl(ti + 1);
    const bool local = (ti >= nctx);
    const int kr = rlo + (ti - nctx);
#pragma unroll
    for (int s = 0; s < NS; ++s) {
      f32x16 sc[2];
#pragma unroll
      for (int kt2 = 0; kt2 < 2; ++kt2)
#pragma unroll
        for (int i = 0; i < 16; ++i) sc[kt2][i] = 0.f;
      if (!DIFF) {
#pragma unroll
        for (int kt2 = 0; kt2 < 2; ++kt2) {
          bf16x8 kf[4];
#pragma unroll
          for (int ks = 0; ks < 4; ++ks) kf[ks] = *(const bf16x8*)(sK + (kt2 * 32 + r) * 72 + ks * 16 + 8 * h);
          __builtin_amdgcn_sched_barrier(0);
#pragma unroll
          for (int ks = 0; ks < 4; ++ks) sc[kt2] = MFMA32(kf[ks], qf[ks], sc[kt2]);
        }
      } else {
        bf16x8 kf[2][2];
#pragma unroll
        for (int kt2 = 0; kt2 < 2; ++kt2)
#pragma unroll
          for (int ks = 0; ks < 2; ++ks) kf[kt2][ks] = *(const bf16x8*)(sK + (kt2 * 32 + r) * 72 + (s * 2 + ks) * 16 + 8 * h);
        __builtin_amdgcn_sched_barrier(0);
#pragma unroll
        for (int ks = 0; ks < 2; ++ks)
#pragma unroll
          for (int kt2 = 0; kt2 < 2; ++kt2) sc[kt2] = MFMA32(kf[kt2][ks], qf[s * 2 + ks], sc[kt2]);
        __builtin_amdgcn_sched_barrier(0);
      }
      constexpr float KSC = (DIFF ? 0.17677669529663687f : 0.125f) * 1.4426950408889634f;
      float mx = -INFINITY;
      if (MODE == 1) {
#pragma unroll
        for (int kt2 = 0; kt2 < 2; ++kt2)
#pragma unroll
          for (int i = 0; i < 16; ++i) {
            float v = sc[kt2][i] * KSC;
            if (local) {
              int kc = kt2 * 32 + crow(i, h);
              bool valid = (kr >= r0q) && (kr < r0q + 8) && (kc >= c0q) && (kc < c0q + 16);
              int bi = valid ? ((kr - qr + 7) * 31 + (kc - qc + 15)) : 0;
              float bv = sBias[bi];
              v = valid ? v + bv * 1.4426950408889634f : -INFINITY;
            }
            sc[kt2][i] = v;
            mx = fmaxf(mx, v);
          }
      } else {
#pragma unroll
        for (int kt2 = 0; kt2 < 2; ++kt2)
#pragma unroll
          for (int i = 0; i < 16; ++i) mx = fmaxf(mx, sc[kt2][i]);
        mx *= KSC;
      }
      mx = fmaxf(mx, __shfl_xor(mx, 32));
      const float mn = fmaxf(m_[s], mx);
      const float alpha = __builtin_amdgcn_exp2f(m_[s] - mn);
      const bool resc = (mn != m_[s]);
      m_[s] = mn;
      float ls = 0.f;
      if (MODE == 1) {
#pragma unroll
        for (int kt2 = 0; kt2 < 2; ++kt2)
#pragma unroll
          for (int i = 0; i < 16; ++i) { float e = __builtin_amdgcn_exp2f(sc[kt2][i] - mn); sc[kt2][i] = e; ls += e; }
      } else {
        f32x2_t ls2 = {0.f, 0.f};
        const f32x2_t k2 = {KSC, KSC}, mn2 = {-mn, -mn};
#pragma unroll
        for (int kt2 = 0; kt2 < 2; ++kt2)
#pragma unroll
          for (int i = 0; i < 16; i += 2) {
            f32x2_t a = {sc[kt2][i], sc[kt2][i + 1]};
            a = __builtin_elementwise_fma(a, k2, mn2);
            f32x2_t e = {__builtin_amdgcn_exp2f(a[0]), __builtin_amdgcn_exp2f(a[1])};
            sc[kt2][i] = e[0]; sc[kt2][i + 1] = e[1];
            ls2 += e;
          }
        ls = ls2[0] + ls2[1];
      }
      l_[s] = l_[s] * alpha + ls;
      if (__any(resc)) {
#pragma unroll
        for (int dt = 0; dt < 2; ++dt)
#pragma unroll
          for (int i = 0; i < 16; ++i) o[s][dt][i] *= alpha;
      }
#pragma unroll
      for (int kt2 = 0; kt2 < 2; ++kt2)
#pragma unroll
        for (int st = 0; st < 2; ++st) {
          u32x4 pk;
#pragma unroll
          for (int j = 0; j < 4; ++j) pk[j] = pack2(sc[kt2][8 * st + 2 * j], sc[kt2][8 * st + 2 * j + 1]);
          bf16x8 pf = __builtin_bit_cast(bf16x8, pk);
          const int koff = kt2 * 32 + 16 * st + 4 * h;
#pragma unroll
          for (int dt = 0; dt < 2; ++dt) {
            u32x2 lo = *(const u32x2*)(sV + (dt * 32 + r) * 72 + koff);
            u32x2 hi = *(const u32x2*)(sV + (dt * 32 + r) * 72 + koff + 8);
            u32x4 vv; vv[0] = lo[0]; vv[1] = lo[1]; vv[2] = hi[0]; vv[3] = hi[1];
            o[s][dt] = MFMA32(__builtin_bit_cast(bf16x8, vv), pf, o[s][dt]);
          }
        }
    }
  }
  float inv[NS];
#pragma unroll
  for (int s = 0; s < NS; ++s) { float lt = l_[s] + __shfl_xor(l_[s], 32); inv[s] = 1.f / lt; }
  if (!DIFF) {
#pragma unroll
    for (int dt = 0; dt < 2; ++dt)
#pragma unroll
      for (int i = 0; i < 16; ++i) sO[r * 72 + dt * 32 + crow(i, h)] = (u16)f2bf(o[0][dt][i] * inv[0]);
  } else {
    const float lam_init = 0.8f - 0.6f * __expf(-0.3f * (float)l);
    const float* dl = p.in[20] + l * 128;
    float s01 = 0.f, s23 = 0.f;
    for (int i = 0; i < 32; ++i) { s01 += dl[i] * dl[32 + i]; s23 += dl[64 + i] * dl[96 + i]; }
    const float lam = __expf(s01) - __expf(s23) + lam_init;
    const float* sg = p.in[21] + l * 64;
    float ss = 0.f;
#pragma unroll
    for (int dt = 0; dt < 2; ++dt)
#pragma unroll
      for (int i = 0; i < 16; ++i) { float v = o[0][dt][i] * inv[0] - lam * o[NS - 1][dt][i] * inv[NS - 1]; o[0][dt][i] = v; ss += v * v; }
    ss += __shfl_xor(ss, 32);
    const float rs = rsqrtf(ss * (1.f / 64.f) + EPS) * (1.f - lam_init);
#pragma unroll
    for (int dt = 0; dt < 2; ++dt)
#pragma unroll
      for (int i = 0; i < 16; ++i) { int d = dt * 32 + crow(i, h); sO[r * 72 + d] = (u16)f2bf(o[0][dt][i] * rs * sg[d]); }
  }
  __syncthreads();
  {
    u16* mix = wsp<u16>(p, OFF_MIX);
    const int tok0 = path * TP + b * L + qpos0 + w * 32;
    const int colb = (DIFF ? 512 : 256) + hd * 64;
#pragma unroll
    for (int i = 0; i < 4; ++i) {
      int c = lane + 64 * i, q = c >> 3, dc = c & 7;
      u32x4 v = *(const u32x4*)(sO + q * 72 + dc * 8);
      *(u32x4*)(mix + (size_t)(tok0 + q) * 1024 + colb + dc * 8) = v;
    }
  }
  __syncthreads();
}

DI void conv_item(const Params& p, int l, int item, unsigned char* smem) {
  const int tid = tid_opaque(), lane = tid & 63, w = tid >> 6;
  float* y = (float*)smem;
  const int t0 = item * 32;
  int L, pos0, tseq0;
  if (t0 < TP) { L = 256; pos0 = t0 & 255; tseq0 = t0 - pos0; } else { L = 4096; pos0 = (t0 - TP) & 4095; tseq0 = t0 - pos0; }
  const u16* ca = wsp<u16>(p, OFF_CONVA);
  const u16* cgp = wsp<u16>(p, OFF_CONVG);
  const int c = tid;
  for (int j = 0; j < 62; ++j) {
    int pos = pos0 - 15 + j;
    float v = 0.f;
    if (pos >= 0 && pos < L) {
      size_t idx = (size_t)(tseq0 + pos) * 256 + c;
      v = bf1(ca[idx]) * sigmoid_f(bf1(cgp[idx]));
    }
    y[j * 256 + c] = v;
  }
  float wv[31];
  const float* cw = p.in[11] + (size_t)l * 31 * 256 + c;
#pragma unroll
  for (int k = 0; k < 31; ++k) wv[k] = cw[k * 256];
  const float bias = p.in[12][l * 256 + c];
  float acc[32];
  __syncthreads();
#pragma unroll
  for (int i = 0; i < 32; ++i) {
    float a = bias;
#pragma unroll
    for (int k = 0; k < 31; ++k) a += y[(i + k) * 256 + c] * wv[k];
    acc[i] = a;
  }
  __syncthreads();
#pragma unroll
  for (int i = 0; i < 32; ++i) y[i * 256 + c] = acc[i];
  __syncthreads();
  const float* lg = p.in[13] + l * 256;
  const float* lb = p.in[14] + l * 256;
  u16* mix = wsp<u16>(p, OFF_MIX);
#pragma nounroll
  for (int ii = 0; ii < 8; ++ii) {
    int i = w * 8 + ii;
    float v[4]; float s = 0.f;
#pragma unroll
    for (int q = 0; q < 4; ++q) { v[q] = y[i * 256 + lane + 64 * q]; s += v[q]; }
    s = wave_sum(s);
    float mu = s * (1.f / 256.f);
    float vs = 0.f;
#pragma unroll
    for (int q = 0; q < 4; ++q) { float d = v[q] - mu; vs += d * d; }
    vs = wave_sum(vs);
    float rs = rsqrtf(vs * (1.f / 256.f) + EPS);
#pragma unroll
    for (int q = 0; q < 4; ++q) {
      int cc = lane + 64 * q;
      float z = (v[q] - mu) * rs * lg[cc] + lb[cc];
      mix[(size_t)(t0 + i) * 1024 + cc] = (u16)f2bf(z * sigmoid_f(z));
    }
  }
  __syncthreads();
}

DI void gmlp_item(const Params& p, int l, int item, unsigned char* smem) {
  const int tid = tid_opaque(), lane = tid & 63, w = tid >> 6, r = lane & 31, h = lane >> 5;
  const int n = item >> 2, g = item & 3;
  const int t0 = n * 128;
  u16* vnT = (u16*)smem;
  float* smu = (float*)(smem + 17408);
  float* srs = smu + 128;
  const u16* gv = wsp<u16>(p, OFF_GV);
  const u16* gu = wsp<u16>(p, OFF_GU);
  if (tid < 128) {
    const u16* rowp = gv + (size_t)(t0 + tid) * 256;
    float s = 0.f;
    for (int q = 0; q < 32; ++q) {
      u32x4 v = *(const u32x4*)(rowp + q * 8);
#pragma unroll
      for (int j = 0; j < 4; ++j) s += bf_lo(v[j]) + bf_hi(v[j]);
    }
    float mu = s * (1.f / 256.f);
    float vs = 0.f;
    for (int q = 0; q < 32; ++q) {
      u32x4 v = *(const u32x4*)(rowp + q * 8);
#pragma unroll
      for (int j = 0; j < 4; ++j) { float a = bf_lo(v[j]) - mu, bq = bf_hi(v[j]) - mu; vs += a * a + bq * bq; }
    }
    smu[tid] = mu; srs[tid] = rsqrtf(vs * (1.f / 256.f) + EPS);
  }
  __syncthreads();
  {
    const int j = tid & 127, chalf = tid >> 7;
    const float mu = smu[j], rs = srs[j];
    const u16* rowp = gv + (size_t)(t0 + j) * 256 + g * 64 + chalf * 32;
    const float* lg = p.in[22] + l * 256 + g * 64 + chalf * 32;
    const float* lb = p.in[23] + l * 256 + g * 64 + chalf * 32;
#pragma unroll
    for (int q = 0; q < 4; ++q) {
      u32x4 v = *(const u32x4*)(rowp + q * 8);
#pragma unroll
      for (int jj = 0; jj < 4; ++jj) {
        int c0 = q * 8 + jj * 2;
        float a = (bf_lo(v[jj]) - mu) * rs * lg[c0] + lb[c0];
        float bq = (bf_hi(v[jj]) - mu) * rs * lg[c0 + 1] + lb[c0 + 1];
        vnT[(chalf * 32 + c0) * 136 + j] = (u16)f2bf(a);
        vnT[(chalf * 32 + c0 + 1) * 136 + j] = (u16)f2bf(bq);
      }
    }
  }
  __syncthreads();
  f32x16 acc[2];
#pragma unroll
  for (int nt = 0; nt < 2; ++nt)
#pragma unroll
    for (int i = 0; i < 16; ++i) acc[nt][i] = 0.f;
  const u16* wsg = wsp<u16>(p, OFF_GWS) + ((size_t)(l * 4 + g) * 128 + w * 32 + r) * 128;
#pragma unroll
  for (int ks = 0; ks < 8; ++ks) {
    bf16x8 a = *(const bf16x8*)(wsg + ks * 16 + 8 * h);
#pragma unroll
    for (int nt = 0; nt < 2; ++nt) {
      bf16x8 bq = *(const bf16x8*)(vnT + (nt * 32 + r) * 136 + ks * 16 + 8 * h);
      acc[nt] = MFMA32(a, bq, acc[nt]);
    }
  }
  const float* bs = p.in[25] + (size_t)(l * 4 + g) * 128;
  u16* mix = wsp<u16>(p, OFF_MIX);
#pragma unroll
  for (int nt = 0; nt < 2; ++nt)
#pragma unroll
    for (int i = 0; i < 16; ++i) {
      int ir = w * 32 + crow(i, h), cc = nt * 32 + r;
      float u = bf1(gu[(size_t)(t0 + ir) * 256 + g * 64 + cc]);
      mix[(size_t)(t0 + ir) * 1024 + 768 + g * 64 + cc] = (u16)f2bf(u * (acc[nt][i] + bs[ir]));
    }
  __syncthreads();
}

DI void phase_mix(const Params& p, int l, unsigned char* smem, int rep = 0) {
  int* ctr = wsp<int>(p, OFF_CTR) + l + 2 * rep;
  int* sitem = (int*)(smem + SMEM_BYTES - 16);
  while (true) {
    __syncthreads();
    if (threadIdx.x == 0) *sitem = atomicAdd(ctr, 1);
    __syncthreads();
    const int item = *sitem;
    __syncthreads();
    if (item >= (l == 0 ? 3104 : 2560)) break;
    if (item < 256) { if (MIXMASK & 1) attn_item<3>(p, l, item, smem); }
    else if (item < 512) { if (MIXMASK & 2) attn_item<1>(p, l, item - 256, smem); }
    else if (item < 768) { if (MIXMASK & 4) attn_item<2>(p, l, item - 512, smem); }
    else if (item < 1024) { if (MIXMASK & 8) attn_item<0>(p, l, item - 768, smem); }
    else if (item < 1536) { if (MIXMASK & 16) gmlp_item(p, l, item - 1024, smem); }
    else if (item < 2048) { if (MIXMASK & 32) conv_item(p, l, item - 1536, smem); }
    else if (item < 2560) {
      const int q = item - 2048, tab = q >> 8, row0 = l * 16384 + (q & 255) * 64;
      quant_rows64(p.in[tab == 0 ? 29 : 30], p.ws + (tab == 0 ? OFF_PU : OFF_PV), wsp<float>(p, tab == 0 ? OFF_SU : OFF_SV), row0);
    } else if (item < 2816) {
      fusedwq_item(p, item - 2560, smem);
    } else {
#pragma nounroll
      for (int j = 0; j < 4; ++j) {
        const int tt = (item - 2816) * 4 + j;
        const int ti = tt < 512 ? 1280 + tt : 640 + (tt - 512);
        transpose_item(p, ti, (float*)smem);
      }
    }
  }
}

DI void phase_outproj(const Params& p, int l, unsigned char* smem) {
  const int tid = tid_opaque(), lane = tid & 63, w = tid >> 6, r = lane & 31, h = lane >> 5;
  const int wm = w >> 1, wn = w & 1;
  const u16* A = wsp<u16>(p, OFF_MIX);
  const u16* Bt = wsp<u16>(p, OFF_WTOUT) + (size_t)l * 1024 * 1024;
  float* xmid = wsp<float>(p, OFF_XMID);
  GemmPre pre;
  gemm_prefetch(tid, A, Bt, 1024, ((int)blockIdx.x >> 3) * 128, ((int)blockIdx.x & 7) * 128, pre);
  for (int tile = blockIdx.x; tile < 128 * 8; tile += gridDim.x) {
    int mt_ = tile >> 3, nt_ = tile & 7;
    const int m0 = mt_ * 128, n0 = nt_ * 128;
    f32x16 acc[2][2];
    gemm_main<true>(tid, A, Bt, 1024, m0, n0, (u16*)smem, acc, 0, 0, &pre);
    { const int nx = tile + gridDim.x; if (nx < 128 * 8) gemm_prefetch(tid, A, Bt, 1024, (nx >> 3) * 128, (nx & 7) * 128, pre); }
    const float* g1 = wsp<float>(p, OFF_MOD) + (size_t)(l * 3 + mod_row(m0)) * 6144 + 2048;
    acc_to_lds<132>(tid, acc, (float*)smem);
    __syncthreads();
    {
      const float* Ct = (const float*)smem;
      const int c = (tid & 31) * 4;
      const float4 gv = *(const float4*)(g1 + n0 + c);
#pragma unroll
      for (int it = 0; it < 16; ++it) {
        const int row = it * 8 + (tid >> 5), m = m0 + row;
        const float4 cv = *(const float4*)(Ct + row * 132 + c);
        const float4 xv = *(const float4*)(xin_row(p, l, m) + n0 + c);
        *(float4*)(xmid + (size_t)m * 1024 + n0 + c) = make_float4(xv.x + gv.x * cv.x, xv.y + gv.y * cv.y, xv.z + gv.z * cv.z, xv.w + gv.w * cv.w);
      }
    }
  }
}

DI void ins16(float (&Lst)[16], float key) {
#pragma unroll
  for (int j = 15; j >= 1; --j) Lst[j] = __builtin_amdgcn_fmed3f(key, Lst[j - 1], Lst[j]);
  Lst[0] = fmaxf(key, Lst[0]);
}

DI void phase_peerq(const Params& p, int l, unsigned char* smem) {
  const int tid = tid_opaque(), lane = tid & 63, w = tid >> 6, r = lane & 31, h = lane >> 5;
  const int wm = w >> 1, wn = w & 1;
  const u16* A = wsp<u16>(p, OFF_H);
  const u16* Bt = wsp<u16>(p, OFF_WTQ) + (size_t)l * 2048 * 1024;
  u16* sQ = (u16*)smem;
  u16* sS = sQ + 128 * 136;
  float* Ct = (float*)smem;
  u32* tmpl = (u32*)(smem + 66048);
  float* ltmp = wsp<float>(p, OFF_LTMP) + (size_t)blockIdx.x * 4096;
  GemmPre pre;
  gemm_prefetch(tid, A, Bt, 1024, ((int)blockIdx.x >> 3) * 128, (((int)blockIdx.x & 7) * 2) * 128, pre);
  for (int item = blockIdx.x; item < 1024; item += gridDim.x) {
    const int m0 = (item >> 3) * 128, hd = item & 7;
#pragma nounroll
    for (int pp = 0; pp < 2; ++pp) {
      f32x16 acc[2][2];
      gemm_main<true>(tid, A, Bt, 1024, m0, (hd * 2 + pp) * 128, (u16*)smem, acc, 0, 0, &pre);
      {
        const int nitem = pp == 0 ? item : item + (int)gridDim.x, npp = pp ^ 1;
        if (nitem < 1024) gemm_prefetch(tid, A, Bt, 1024, (nitem >> 3) * 128, ((nitem & 7) * 2 + npp) * 128, pre);
      }
      acc_to_lds(tid, acc, Ct);
      __syncthreads();
      const int row = tid & 127, half = tid >> 7;
      float Lc[16];
#pragma unroll
      for (int j = 0; j < 16; ++j) Lc[j] = -INFINITY;
#pragma nounroll
      for (int j0 = 0; j0 < 64; j0 += 8) {
#pragma unroll
        for (int jj = 0; jj < 8; ++jj) {
          int j = j0 + jj;
          float v = Ct[row * 129 + half * 64 + j];
          float key = __uint_as_float((__float_as_uint(v) & 0xffffff80u) | (u32)(half * 64 + j));
          ins16(Lc, key);
        }
      }
      if (half == 1) {
#pragma unroll
        for (int j = 0; j < 16; ++j) tmpl[row * 16 + j] = __float_as_uint(Lc[j]);
      }
      __syncthreads();
      if (half == 0) {
#pragma unroll
        for (int j = 0; j < 16; ++j) ins16(Lc, __uint_as_float(tmpl[row * 16 + j]));
#pragma unroll
        for (int j = 0; j < 16; j += 4) *(float4*)(ltmp + (pp * 128 + row) * 16 + j) = make_float4(Lc[j], Lc[j + 1], Lc[j + 2], Lc[j + 3]);
      }
    }
    __syncthreads();
    u32* lists = (u32*)smem;
    if (tid < 128) {
      const int row = tid;
      float La[16], Lb[16];
#pragma unroll
      for (int j = 0; j < 16; j += 4) { float4 q = *(const float4*)(ltmp + row * 16 + j); La[j] = q.x; La[j + 1] = q.y; La[j + 2] = q.z; La[j + 3] = q.w; }
#pragma unroll
      for (int j = 0; j < 16; j += 4) { float4 q = *(const float4*)(ltmp + (128 + row) * 16 + j); Lb[j] = q.x; Lb[j + 1] = q.y; Lb[j + 2] = q.z; Lb[j + 3] = q.w; }
#pragma unroll
      for (int j = 0; j < 16; ++j) { lists[(row * 2 + 0) * 16 + j] = __float_as_uint(La[j]); lists[(row * 2 + 1) * 16 + j] = __float_as_uint(Lb[j]); }
      float Tl[16];
#pragma unroll
      for (int j = 0; j < 16; ++j) Tl[j] = -INFINITY;
#pragma unroll
      for (int i = 0; i < 16; ++i) {
        const float va = __uint_as_float(__float_as_uint(La[i]) & 0xffffff80u);
#pragma unroll
        for (int j = 0; j < 16; ++j) {
          if ((i + 1) * (j + 1) <= 16) {
            float vb = __uint_as_float(__float_as_uint(Lb[j]) & 0xffffff80u);
            float sum = va + vb;
            float key = __uint_as_float((__float_as_uint(sum) & 0xffffff00u) | (u32)(i * 16 + j));
            ins16(Tl, key);
          }
        }
      }
      float ev[16]; int ei[16];
      float mx = 0.f, den = 0.f;
#pragma unroll
      for (int k = 0; k < 16; ++k) {
        u32 code = __float_as_uint(Tl[k]) & 255u;
        u32 ka = lists[(row * 2 + 0) * 16 + (code >> 4)];
        u32 kb = lists[(row * 2 + 1) * 16 + (code & 15u)];
        float s = __uint_as_float(ka & 0xffffff80u) + __uint_as_float(kb & 0xffffff80u);
        if (k == 0) mx = s;
        float e = __expf(s - mx);
        ev[k] = e; den += e;
        ei[k] = (int)((ka & 127u) * 128u + (kb & 127u));
      }
      const float rden = 1.f / den;
      int* eo = wsp<int>(p, OFF_EIDX) + ((size_t)(m0 + row) * 8 + hd) * 16;
      float* go = wsp<float>(p, OFF_GATE) + ((size_t)(m0 + row) * 8 + hd) * 16;
#pragma unroll
      for (int k = 0; k < 16; k += 4) {
        *(int4*)(eo + k) = make_int4(ei[k], ei[k + 1], ei[k + 2], ei[k + 3]);
        *(float4*)(go + k) = make_float4(ev[k] * rden, ev[k + 1] * rden, ev[k + 2] * rden, ev[k + 3] * rden);
      }
    }
  }
}

typedef float f32x2 __attribute__((ext_vector_type(2)));
typedef _Float16 h2_t __attribute__((ext_vector_type(2)));
DI float dot16f4h(const u32x2& a, const h2_t (&hh)[8]) {
  float s = 0.f;
  s = __builtin_amdgcn_fdot2(__builtin_amdgcn_cvt_scalef32_pk_f16_fp4(a[0], 1.0f, 0), hh[0], s, false);
  s = __builtin_amdgcn_fdot2(__builtin_amdgcn_cvt_scalef32_pk_f16_fp4(a[0], 1.0f, 1), hh[1], s, false);
  s = __builtin_amdgcn_fdot2(__builtin_amdgcn_cvt_scalef32_pk_f16_fp4(a[0], 1.0f, 2), hh[2], s, false);
  s = __builtin_amdgcn_fdot2(__builtin_amdgcn_cvt_scalef32_pk_f16_fp4(a[0], 1.0f, 3), hh[3], s, false);
  s = __builtin_amdgcn_fdot2(__builtin_amdgcn_cvt_scalef32_pk_f16_fp4(a[1], 1.0f, 0), hh[4], s, false);
  s = __builtin_amdgcn_fdot2(__builtin_amdgcn_cvt_scalef32_pk_f16_fp4(a[1], 1.0f, 1), hh[5], s, false);
  s = __builtin_amdgcn_fdot2(__builtin_amdgcn_cvt_scalef32_pk_f16_fp4(a[1], 1.0f, 2), hh[6], s, false);
  s = __builtin_amdgcn_fdot2(__builtin_amdgcn_cvt_scalef32_pk_f16_fp4(a[1], 1.0f, 3), hh[7], s, false);
  return s;
}
DI float dot16f4(const u32x2& a, const float (&hf)[16]) {
  f32x2 s = {0.f, 0.f};
#pragma unroll
  for (int q = 0; q < 2; ++q) {
#pragma unroll
    for (int b = 0; b < 4; ++b) {
      f32x2 e;
      if (b == 0) e = __builtin_amdgcn_cvt_scalef32_pk_f32_fp4(a[q], 1.0f, 0);
      else if (b == 1) e = __builtin_amdgcn_cvt_scalef32_pk_f32_fp4(a[q], 1.0f, 1);
      else if (b == 2) e = __builtin_amdgcn_cvt_scalef32_pk_f32_fp4(a[q], 1.0f, 2);
      else e = __builtin_amdgcn_cvt_scalef32_pk_f32_fp4(a[q], 1.0f, 3);
      f32x2 hv = {hf[8 * q + 2 * b], hf[8 * q + 2 * b + 1]};
      s = __builtin_elementwise_fma(e, hv, s);
    }
  }
  return s[0] + s[1];
}

DI void phase_peer(const Params& p, int l, unsigned char* smem) {
  const int tid = tid_opaque(), lane = tid & 63, w = tid >> 6;
  const int gw = blockIdx.x * 4 + w, nw = gridDim.x * 4;
  const unsigned char* PU = p.ws + OFF_PU + (size_t)l * 16384 * 512;
  const unsigned char* PV = p.ws + OFF_PV + (size_t)l * 16384 * 512;
  const float* SU = wsp<float>(p, OFF_SU) + l * 16384;
  const float* SV = wsp<float>(p, OFF_SV) + l * 16384;
  u16* H = wsp<u16>(p, OFF_H);
  const int* EI = wsp<int>(p, OFF_EIDX);
  const float* GT = wsp<float>(p, OFF_GATE);
  const float* xmid = wsp<float>(p, OFF_XMID);
  float* wbuf = (float*)smem + w * 1024;
  const __amdgpu_buffer_rsrc_t rsU = __builtin_amdgcn_make_buffer_rsrc((void*)PU, (short)0, 16384 * 512, 0x00020000);
  const __amdgpu_buffer_rsrc_t rsV = __builtin_amdgcn_make_buffer_rsrc((void*)PV, (short)0, 16384 * 512, 0x00020000);
  const unsigned loff8 = (unsigned)lane * 8u;
  const bool b0 = lane & 1, b1 = lane & 2, b2 = lane & 4, b3 = lane & 8, b4 = lane & 16;
  const int l31 = lane & 31;
#pragma nounroll
  for (int tb = gw; tb < T; tb += nw * 8) {
#pragma nounroll
    for (int i = 0; i < 8; ++i) {
      const int t = tb + i * nw;
      if (t >= T) break;
      h2_t hf[8];
      {
        u32x4 ha = *(const u32x4*)(H + (size_t)t * 1024 + lane * 16);
        u32x4 hb = *(const u32x4*)(H + (size_t)t * 1024 + lane * 16 + 8);
#pragma unroll
        for (int q = 0; q < 4; ++q) {
          h2_t x = {(_Float16)bf_lo(ha[q]), (_Float16)bf_hi(ha[q])}; hf[q] = x;
          h2_t y = {(_Float16)bf_lo(hb[q]), (_Float16)bf_hi(hb[q])}; hf[4 + q] = y;
        }
      }
      int e8[8];
#pragma unroll
      for (int hd = 0; hd < 8; ++hd) e8[hd] = EI[(size_t)t * 128 + hd * 16 + (lane & 15)];
      u32x2 ruA[16], ruB[16];
#define P1_LOAD(R, HD) { _Pragma("unroll") for (int k = 0; k < 16; ++k) { const int ek = __builtin_amdgcn_readlane(e8[HD], k); R[k] = __builtin_bit_cast(u32x2, __builtin_amdgcn_raw_buffer_load_b64(rsU, (int)loff8, ek * 512, 0)); } }
#define P1_COMP(R, HD) { \
        const float g = GT[(size_t)t * 128 + (HD) * 16 + (lane & 15)]; \
        const float su = SU[e8[HD]], sv = SV[e8[HD]]; \
        float part[16]; \
        _Pragma("unroll") for (int k = 0; k < 16; ++k) part[k] = dot16f4h(R[k], hf); \
        float q8[8], q4[4], q2[2], q1; \
        _Pragma("unroll") for (int j = 0; j < 8; ++j) { float keep = b0 ? part[2 * j + 1] : part[2 * j]; float send = b0 ? part[2 * j] : part[2 * j + 1]; q8[j] = keep + swz_xor(send, 1); } \
        _Pragma("unroll") for (int j = 0; j < 4; ++j) { float keep = b1 ? q8[2 * j + 1] : q8[2 * j]; float send = b1 ? q8[2 * j] : q8[2 * j + 1]; q4[j] = keep + swz_xor(send, 2); } \
        _Pragma("unroll") for (int j = 0; j < 2; ++j) { float keep = b2 ? q4[2 * j + 1] : q4[2 * j]; float send = b2 ? q4[2 * j] : q4[2 * j + 1]; q2[j] = keep + swz_xor(send, 4); } \
        { float keep = b3 ? q2[1] : q2[0]; float send = b3 ? q2[0] : q2[1]; q1 = keep + swz_xor(send, 8); } \
        q1 += swz_xor(q1, 16); \
        q1 += __shfl_xor(q1, 32); \
        const float wgt = gelu_f(q1 * su) * g * sv; \
        if (lane < 16) wbuf[i * 128 + (HD) * 16 + lane] = wgt; }
      P1_LOAD(ruA, 0)
#pragma unroll
      for (int hd = 0; hd < 8; hd += 2) {
        P1_LOAD(ruB, hd + 1)
        P1_COMP(ruA, hd)
        if (hd + 2 < 8) P1_LOAD(ruA, hd + 2)
        P1_COMP(ruB, hd + 1)
      }
#undef P1_LOAD
#undef P1_COMP
    }
#pragma nounroll
    for (int i = 0; i < 8; ++i) {
      const int t = tb + i * nw;
      if (t >= T) break;
      float acc[16];
#pragma unroll
      for (int j = 0; j < 16; ++j) acc[j] = 0.f;
      int e8[8];
#pragma unroll
      for (int hd = 0; hd < 8; ++hd) e8[hd] = EI[(size_t)t * 128 + hd * 16 + (lane & 15)];
      u32x2 rvA[16], rvB[16];
#define P2_LOAD(R, HD) { _Pragma("unroll") for (int k = 0; k < 16; ++k) { const int ek = __builtin_amdgcn_readlane(e8[HD], k); R[k] = __builtin_bit_cast(u32x2, __builtin_amdgcn_raw_buffer_load_b64(rsV, (int)loff8, ek * 512, 0)); } }
#define P2_COMP(R, HD) { \
        const float wgt = wbuf[i * 128 + (HD) * 16 + (lane & 15)]; \
        _Pragma("unroll") for (int k = 0; k < 16; ++k) { \
          const float wk = __uint_as_float(__builtin_amdgcn_readlane(__float_as_uint(wgt), k)); \
          _Pragma("unroll") for (int q = 0; q < 2; ++q) { \
            f32x2 e0 = __builtin_amdgcn_cvt_scalef32_pk_f32_fp4(R[k][q], 1.0f, 0); \
            f32x2 e1 = __builtin_amdgcn_cvt_scalef32_pk_f32_fp4(R[k][q], 1.0f, 1); \
            f32x2 e2 = __builtin_amdgcn_cvt_scalef32_pk_f32_fp4(R[k][q], 1.0f, 2); \
            f32x2 e3 = __builtin_amdgcn_cvt_scalef32_pk_f32_fp4(R[k][q], 1.0f, 3); \
            acc[8 * q] += wk * e0[0]; acc[8 * q + 1] += wk * e0[1]; acc[8 * q + 2] += wk * e1[0]; acc[8 * q + 3] += wk * e1[1]; \
            acc[8 * q + 4] += wk * e2[0]; acc[8 * q + 5] += wk * e2[1]; acc[8 * q + 6] += wk * e3[0]; acc[8 * q + 7] += wk * e3[1]; } } }
      P2_LOAD(rvA, 0)
#pragma unroll
      for (int hd = 0; hd < 8; hd += 2) {
        P2_LOAD(rvB, hd + 1)
        P2_COMP(rvA, hd)
        if (hd + 2 < 8) P2_LOAD(rvA, hd + 2)
        P2_COMP(rvB, hd + 1)
      }
#undef P2_LOAD
#undef P2_COMP
      const float* g2 = wsp<float>(p, OFF_MOD) + (size_t)(l * 3 + mod_row(t)) * 6144 + 5120;
      float* yo = p.out + (size_t)t * 1024;
      const float* xm = xmid + (size_t)t * 1024;
      float ss = 0.f;
#pragma unroll
      for (int q = 0; q < 4; ++q) {
        int n = lane * 16 + q * 4;
        float4 x0 = *(const float4*)(xm + n);
        float4 ga = *(const float4*)(g2 + n);
        acc[4 * q] = x0.x + ga.x * acc[4 * q]; acc[4 * q + 1] = x0.y + ga.y * acc[4 * q + 1];
        acc[4 * q + 2] = x0.z + ga.z * acc[4 * q + 2]; acc[4 * q + 3] = x0.w + ga.w * acc[4 * q + 3];
        *(float4*)(yo + n) = make_float4(acc[4 * q], acc[4 * q + 1], acc[4 * q + 2], acc[4 * q + 3]);
        ss += acc[4 * q] * acc[4 * q] + acc[4 * q + 1] * acc[4 * q + 1] + acc[4 * q + 2] * acc[4 * q + 2] + acc[4 * q + 3] * acc[4 * q + 3];
      }
      if (l == 0) {
        ss = wave_sum(ss);
        const float rs = rsqrtf(ss * (1.f / 1024.f) + EPS);
        const float* gam = p.in[8] + 1024;
        const float* md = wsp<float>(p, OFF_MOD) + (size_t)(3 + mod_row(t)) * 6144;
        float hv[16];
#pragma unroll
        for (int q = 0; q < 4; ++q) {
          int n = lane * 16 + q * 4;
          float4 gg = *(const float4*)(gam + n), sh = *(const float4*)(md + n), sc = *(const float4*)(md + 1024 + n);
          hv[4 * q] = acc[4 * q] * rs * gg.x * (1.f + sc.x) + sh.x; hv[4 * q + 1] = acc[4 * q + 1] * rs * gg.y * (1.f + sc.y) + sh.y;
          hv[4 * q + 2] = acc[4 * q + 2] * rs * gg.z * (1.f + sc.z) + sh.z; hv[4 * q + 3] = acc[4 * q + 3] * rs * gg.w * (1.f + sc.w) + sh.w;
        }
        st8(H + (size_t)t * 1024 + lane * 16, hv);
        st8(H + (size_t)t * 1024 + lane * 16 + 8, hv + 8);
      }
    }
  }
}

#define XB_TMO      128
#define XB_XCNT(j)  (256  + 64 * (j))
#define XB_XSUB(j)  (1280 + 64 * (j))
#define XB_XGEN(j)  (2304 + 64 * (j))
#define XB_TOP      3328
#define XB_TOPGEN   3392
#define XCD_BAR_WORDS 3456
#define XB_SPIN_CAP (1u << 20)
#define LAS __attribute__((address_space(3)))
DI unsigned xb_ld(unsigned* p) { return __hip_atomic_load(p, __ATOMIC_RELAXED, __HIP_MEMORY_SCOPE_AGENT); }
DI unsigned xb_add(unsigned* p, unsigned v) { return __hip_atomic_fetch_add(p, v, __ATOMIC_RELAXED, __HIP_MEMORY_SCOPE_AGENT); }
DI unsigned xb_xcc_id() { return (unsigned)__builtin_amdgcn_s_getreg((3 << 11) | 20) & 0xFu; }
#define XB_SPIN(cond, bar) do { unsigned _sp = 0; while (cond) { __builtin_amdgcn_s_sleep(1); \
    if ((++_sp & 255u) == 0u) { if (xb_ld(&(bar)[XB_TMO])) break; if (_sp > XB_SPIN_CAP) { atomicAdd(&(bar)[XB_TMO], 1u); break; } } } } while (0)
struct XcdBarrier { unsigned* bar; unsigned x; volatile LAS unsigned* st; };
DI XcdBarrier xcd_barrier_post(unsigned* bar, volatile LAS unsigned* st) {
  XcdBarrier b; b.bar = bar; b.x = xb_xcc_id(); b.st = st;
  if (threadIdx.x == 0) (void)xb_add(&bar[XB_XCNT(b.x)], 1u);
  return b;
}
DI void xcd_barrier_complete(unsigned* bar, unsigned x, unsigned& nloc, unsigned& nx) {
  const unsigned G = gridDim.x * gridDim.y * gridDim.z;
  unsigned sum, cnt, mine, sp = 0u;
  for (;;) {
    sum = 0u; cnt = 0u; mine = 0u;
#pragma unroll
    for (unsigned j = 0; j < 16; ++j) { const unsigned c = xb_ld(&bar[XB_XCNT(j)]); sum += c; cnt += (c > 0u) ? 1u : 0u; mine = (j == x) ? c : mine; }
    if (sum == G) break;
    __builtin_amdgcn_s_sleep(1);
    if ((++sp & 255u) == 0u) { if (xb_ld(&bar[XB_TMO])) break; if (sp > XB_SPIN_CAP) { atomicAdd(&bar[XB_TMO], 1u); break; } }
  }
  nloc = mine > 0u ? mine : 1u; nx = cnt > 0u ? cnt : 1u;
}
DI void xcd_barrier(const XcdBarrier& b) {
  asm volatile("s_waitcnt vmcnt(0)" ::: "memory");
  __syncthreads();
  if (threadIdx.x == 0) {
    unsigned* bar = b.bar;
    __builtin_amdgcn_s_waitcnt(0);
    unsigned nloc = b.st[0], nx = b.st[1];
    if (nloc == 0u) { xcd_barrier_complete(bar, b.x, nloc, nx); b.st[0] = nloc; b.st[1] = nx; }
    const unsigned old = xb_add(&bar[XB_XSUB(b.x)], 1u);
    const unsigned gen = old / nloc;
    if (old + 1u == (gen + 1u) * nloc) {
      __builtin_amdgcn_fence(__ATOMIC_RELEASE, "agent");
      asm volatile("s_waitcnt vmcnt(0)" ::: "memory");
      const unsigned og = xb_add(&bar[XB_TOP], 1u);
      const unsigned tg = og / nx;
      if (og + 1u == (tg + 1u) * nx) xb_add(&bar[XB_TOPGEN], 1u);
      else XB_SPIN(xb_ld(&bar[XB_TOPGEN]) == tg, bar);
      __builtin_amdgcn_fence(__ATOMIC_ACQUIRE, "agent");
      xb_add(&bar[XB_XGEN(b.x)], 1u);
      asm volatile("s_waitcnt vmcnt(0)" ::: "memory");
    } else {
      XB_SPIN(xb_ld(&bar[XB_XGEN(b.x)]) == gen, bar);
      __builtin_amdgcn_fence(__ATOMIC_ACQUIRE, "agent");
      asm volatile("s_waitcnt vmcnt(0)" ::: "memory");
    }
  }
  __syncthreads();
}

__global__ void __launch_bounds__(256, 2) mega(Params p, int ph_lo, int ph_hi) {
  __shared__ __attribute__((aligned(16))) unsigned char smem[SMEM_BYTES];
  __shared__ uint4 xb_words;
  cg::grid_group grid = cg::this_grid();
  if (threadIdx.x == 0) xb_words = make_uint4(0u, 0u, 0u, 0u);
  __syncthreads();
  XcdBarrier xb = xcd_barrier_post((unsigned*)(p.ws + OFF_BAR), (volatile LAS unsigned*)&xb_words);
  for (int ph = ph_lo; ph < ph_hi; ++ph) {
    if (ph == 8) continue;
    if (ph == 0) phase0(p, smem);
    else {
      const int l = (ph - 1) / 7, s = (ph - 1) % 7;
      if (s == 0) phase_norm(p, l, 0);
      else if (s == 1) phase_proj(p, l, smem);
      else if (s == 2) phase_mix(p, l, smem);
      else if (s == 3) phase_outproj(p, l, smem);
      else if (s == 4) phase_norm(p, l, 1);
      else if (s == 5) phase_peerq(p, l, smem);
      else phase_peer(p, l, smem);
      if (DUP_PHASE == s) {
        xcd_barrier(xb);
        if (s == 0) phase_norm(p, l, 0);
        else if (s == 1) phase_proj(p, l, smem);
        else if (s == 2) phase_mix(p, l, smem, 1);
        else if (s == 3) phase_outproj(p, l, smem);
        else if (s == 4) phase_norm(p, l, 1);
        else if (s == 5) phase_peerq(p, l, smem);
        else phase_peer(p, l, smem);
      }
    }
    if (ph + 1 < ph_hi) { if (ph_hi < 0) grid.sync(); xcd_barrier(xb); for (int q = 0; q < EXTRA_SYNCS; ++q) xcd_barrier(xb); }
  }
}

extern "C" void kernel_launch(void* const* d_in, const int* in_sizes, int n_in, void* d_out, int out_size, void* d_ws, size_t ws_size,
                              hipStream_t stream) {
  static int grid_blocks = 0;
  if (!grid_blocks) {
    int dev = 0, cus = 0, per_cu = 0;
    hipGetDevice(&dev);
    hipDeviceGetAttribute(&cus, hipDeviceAttributeMultiprocessorCount, dev);
    hipOccupancyMaxActiveBlocksPerMultiprocessor(&per_cu, mega, 256, 0);
    if (per_cu < 1) per_cu = 1;
    if (per_cu > 2) per_cu = 2;
    grid_blocks = cus * per_cu;
    if (grid_blocks > 1024) grid_blocks = 1024;
    if (ws_size < WS_END) fprintf(stderr, "kernel_launch: workspace too small (%zu < %zu)\n", ws_size, (size_t)WS_END);
  }
  Params p{};
  for (int i = 0; i < 31; ++i) p.in[i] = (const float*)d_in[i];
  p.out = (float*)d_out;
  p.ws = (unsigned char*)d_ws;
  (void)hipMemsetAsync((unsigned char*)d_ws + OFF_BAR, 0, XCD_BAR_WORDS * 4, stream);
#if COOP
  int lo = 0, hi = PH_END;
  void* args[] = {&p, &lo, &hi};
  hipError_t e = hipLaunchCooperativeKernel((void*)mega, dim3(grid_blocks), dim3(256), args, 0, stream);
  if (e != hipSuccess) fprintf(stderr, "cooperative launch failed: %s (grid %d)\n", hipGetErrorString(e), grid_blocks);
#else
  for (int ph = 0; ph < PH_END; ++ph) hipLaunchKernelGGL(mega, dim3(grid_blocks), dim3(256), 0, stream, p, ph, ph + 1);
#endif
}
```

```cpp
#include <hip/hip_runtime.h>
#include <hip/hip_cooperative_groups.h>
#include <cstdio>
namespace cg = cooperative_groups;

#define DI __device__ __forceinline__
typedef unsigned short u16;
typedef unsigned int u32;
using bf16x8 = __attribute__((ext_vector_type(8))) short;
using f32x16 = __attribute__((ext_vector_type(16))) float;
using u32x4 = __attribute__((ext_vector_type(4))) unsigned;
using u32x2 = __attribute__((ext_vector_type(2))) unsigned;
#define MFMA32(a, b, c) __builtin_amdgcn_mfma_f32_32x32x16_bf16((a), (b), (c), 0, 0, 0)

#ifndef PROBE_EPI4
#define PROBE_EPI4 1
#endif
#ifndef PROBE_EPI2
#define PROBE_EPI2 1
#endif
#ifndef EXTRA_SYNCS
#define EXTRA_SYNCS 0
#endif
#ifndef DUP_PHASE
#define DUP_PHASE -1
#endif
#ifndef MIXMASK
#define MIXMASK 63
#endif
#ifndef PH_END
#define PH_END 15
#endif
#ifndef COOP
#define COOP 1
#endif

constexpr int T = 16384, TP = 8192;
constexpr float EPS = 1e-6f;
constexpr int NPHASE = 15;
constexpr int SMEM_BYTES = 74240;

constexpr size_t OFF_WTIN = 0;
constexpr size_t OFF_WTOUT = OFF_WTIN + 10485760;
constexpr size_t OFF_WTQ = OFF_WTOUT + 4194304;
constexpr size_t OFF_SUBK = OFF_WTQ + 8388608;
constexpr size_t OFF_GWS = OFF_SUBK + 131072;
constexpr size_t OFF_PU = OFF_GWS + 262144;
constexpr size_t OFF_PV = OFF_PU + 67108864;
constexpr size_t OFF_MOD = OFF_PV + 67108864;
constexpr size_t OFF_ROPE = OFF_MOD + 147456;
constexpr size_t OFF_CKNA = OFF_ROPE + 4096;
constexpr size_t OFF_CVNA = OFF_CKNA + 524288;
constexpr size_t OFF_CKD = OFF_CVNA + 524288;
constexpr size_t OFF_CVD = OFF_CKD + 524288;
constexpr size_t OFF_CTR = OFF_CVD + 524288;
constexpr size_t OFF_H = OFF_CTR + 256;
constexpr size_t OFF_CONVA = OFF_H + 33554432;
constexpr size_t OFF_CONVG = OFF_CONVA + 8388608;
constexpr size_t OFF_QNA = OFF_CONVG + 8388608;
constexpr size_t OFF_KNA = OFF_QNA + 8388608;
constexpr size_t OFF_VNAT = OFF_KNA + 8388608;
constexpr size_t OFF_QD = OFF_VNAT + 8388608;
constexpr size_t OFF_KD = OFF_QD + 8388608;
constexpr size_t OFF_VDT = OFF_KD + 8388608;
constexpr size_t OFF_GU = OFF_VDT + 8388608;
constexpr size_t OFF_GV = OFF_GU + 8388608;
constexpr size_t OFF_MIX = OFF_GV + 8388608;
constexpr size_t OFF_XMID = OFF_MIX + 33554432;
constexpr size_t OFF_EIDX = OFF_XMID + 67108864;
constexpr size_t OFF_GATE = OFF_EIDX + 8388608;
constexpr size_t OFF_LTMP = OFF_GATE + 8388608;
constexpr size_t OFF_SU = OFF_LTMP + 16777216;
constexpr size_t OFF_SV = OFF_SU + 131072;
constexpr size_t OFF_BAR = OFF_SV + 131072;
constexpr size_t OFF_WQB = OFF_BAR + 16384;
constexpr size_t WS_END = OFF_WQB + 8388608;

constexpr size_t OUT_NAKV = 16777216;
constexpr size_t OUT_DKV = 25165824;

struct Params {
  const float* in[31];
  float* out;
  unsigned char* ws;
};

DI int tid_opaque() { int t = threadIdx.x; asm volatile("" : "+v"(t)); return t; }
typedef __bf16 bf16x2_t __attribute__((ext_vector_type(2)));
typedef float f32x2_t __attribute__((ext_vector_type(2)));
DI u32 f2bf(float x) { u32 u = __float_as_uint(x); u += 0x7fffu + ((u >> 16) & 1u); return u >> 16; }
DI u32 pack2(float a, float b) { f32x2_t v = {a, b}; return __builtin_bit_cast(u32, __builtin_convertvector(v, bf16x2_t)); }
DI float bf_lo(u32 p) { return __uint_as_float(p << 16); }
DI float bf_hi(u32 p) { return __uint_as_float(p & 0xffff0000u); }
DI float bf1(u16 v) { return __uint_as_float(((u32)v) << 16); }
DI float sigmoid_f(float x) { return __builtin_amdgcn_rcpf(1.f + __expf(-x)); }
DI float gelu_f(float x) {
  float u = 0.7978845608028654f * (x + 0.044715f * x * x * x);
  float e = __expf(2.f * u);
  float t = 1.f - 2.f * __builtin_amdgcn_rcpf(e + 1.f);
  return 0.5f * x * (1.f + t);
}
DI int crow(int i, int h) { return (i & 3) + 8 * (i >> 2) + 4 * h; }
DI int clampi(int v, int lo, int hi) { return v < lo ? lo : (v > hi ? hi : v); }
DI void st8(u16* dst, const float* v) {
  u32x4 o; o[0] = pack2(v[0], v[1]); o[1] = pack2(v[2], v[3]); o[2] = pack2(v[4], v[5]); o[3] = pack2(v[6], v[7]);
  *(u32x4*)dst = o;
}
DI float swz_xor(float v, int d) {
  int r;
  if (d == 1) r = __builtin_amdgcn_ds_swizzle(__float_as_int(v), (1 << 10) | 0x1F);
  else if (d == 2) r = __builtin_amdgcn_ds_swizzle(__float_as_int(v), (2 << 10) | 0x1F);
  else if (d == 4) r = __builtin_amdgcn_ds_swizzle(__float_as_int(v), (4 << 10) | 0x1F);
  else if (d == 8) r = __builtin_amdgcn_ds_swizzle(__float_as_int(v), (8 << 10) | 0x1F);
  else r = __builtin_amdgcn_ds_swizzle(__float_as_int(v), (16 << 10) | 0x1F);
  return __int_as_float(r);
}
DI float wave_sum(float v) {
#pragma unroll
  for (int d = 32; d >= 1; d >>= 1) v += __shfl_xor(v, d);
  return v;
}
DI const float* xin_row(const Params& p, int l, int t) {
  if (l == 0) return t < TP ? p.in[0] + (size_t)t * 1024 : p.in[1] + (size_t)(t - TP) * 1024;
  return p.out + (size_t)t * 1024;
}
DI int mod_row(int t) { return t < TP ? 0 : 1 + ((t - TP) >> 12); }
template <typename Tp> DI Tp* wsp(const Params& p, size_t off) { return (Tp*)(p.ws + off); }

DI void transpose_tile(const float* src, u16* dst, int K, int N, int k0, int n0, float* t) {
  const int tid = tid_opaque();
#pragma unroll
  for (int i = 0; i < 16; ++i) {
    int k = i * 4 + (tid >> 6), n = tid & 63;
    t[k * 65 + n] = src[(size_t)(k0 + k) * N + n0 + n];
  }
  __syncthreads();
  {
    int n = tid >> 2, kq = (tid & 3) * 16;
    float v[16];
#pragma unroll
    for (int j = 0; j < 16; ++j) v[j] = t[(kq + j) * 65 + n];
    u16* d = dst + (size_t)(n0 + n) * K + k0 + kq;
    st8(d, v); st8(d + 8, v + 8);
  }
  __syncthreads();
}

DI void convert_range(const float* src, u16* dst, size_t n8) {
  size_t stride = (size_t)gridDim.x * 256;
  const int tid_ = tid_opaque();
  for (size_t i = (size_t)blockIdx.x * 256 + tid_; i < n8; i += stride) {
    float4 a = ((const float4*)src)[2 * i], b = ((const float4*)src)[2 * i + 1];
    u32x4 o; o[0] = pack2(a.x, a.y); o[1] = pack2(a.z, a.w); o[2] = pack2(b.x, b.y); o[3] = pack2(b.z, b.w);
    ((u32x4*)dst)[i] = o;
  }
}

DI void quant_rows64(const float* src, unsigned char* dst, float* rscale, int row0) {
  const int tid_ = tid_opaque();
  const int lane = tid_ & 63;
  const int nrows = row0 + 64, nw = 1;
#pragma nounroll
  for (int rb = row0 + (tid_ >> 6) * 16; rb < row0 + (tid_ >> 6) * 16 + 16; rb += 2) {
    float4 v[2][4];
    float am[2];
#pragma unroll
    for (int u = 0; u < 2; ++u) {
      const int row = rb + u * nw;
      const float* s = src + (size_t)(row < nrows ? row : rb) * 1024 + lane * 16;
      float a = 0.f;
#pragma unroll
      for (int i = 0; i < 4; ++i) {
        v[u][i] = *(const float4*)(s + i * 4);
        a = fmaxf(a, fmaxf(fmaxf(fabsf(v[u][i].x), fabsf(v[u][i].y)), fmaxf(fabsf(v[u][i].z), fabsf(v[u][i].w))));
      }
      am[u] = a;
    }
#pragma unroll
    for (int u = 0; u < 2; ++u) {
#pragma unroll
      for (int d = 32; d >= 1; d >>= 1) am[u] = fmaxf(am[u], __shfl_xor(am[u], d));
    }
#pragma unroll
    for (int u = 0; u < 2; ++u) {
      const int row = rb + u * nw;
      if (row < nrows) {
        const float sc = am[u] > 0.f ? 6.f / am[u] : 0.f;
        u32x2 o;
#pragma unroll
        for (int hh = 0; hh < 2; ++hh) {
          u32 pk = 0u;
          pk = __builtin_amdgcn_cvt_scalef32_pk_fp4_f32(pk, v[u][2 * hh].x * sc, v[u][2 * hh].y * sc, 1.0f, 0);
          pk = __builtin_amdgcn_cvt_scalef32_pk_fp4_f32(pk, v[u][2 * hh].z * sc, v[u][2 * hh].w * sc, 1.0f, 1);
          pk = __builtin_amdgcn_cvt_scalef32_pk_fp4_f32(pk, v[u][2 * hh + 1].x * sc, v[u][2 * hh + 1].y * sc, 1.0f, 2);
          pk = __builtin_amdgcn_cvt_scalef32_pk_fp4_f32(pk, v[u][2 * hh + 1].z * sc, v[u][2 * hh + 1].w * sc, 1.0f, 3);
          o[hh] = pk;
        }
        *(u32x2*)(dst + (size_t)row * 512 + lane * 8) = o;
        if (lane == 0) rscale[row] = am[u] * (1.f / 6.f);
      }
    }
  }
}

DI void transpose_item(const Params& p, int item, float* sf) {
  const float* src; u16* dst; int N, it;
  if (item < 1280) { it = item; N = 2560; src = p.in[10]; dst = wsp<u16>(p, OFF_WTIN); }
  else if (item < 1792) { it = item - 1280; N = 1024; src = p.in[26]; dst = wsp<u16>(p, OFF_WTOUT); }
  else { it = item - 1792; N = 2048; src = p.in[27]; dst = wsp<u16>(p, OFF_WTQ); }
  int per_layer = 16 * (N / 64);
  int l = it / per_layer, r = it % per_layer;
  int kt = r / (N / 64), nt = r % (N / 64);
  transpose_tile(src + (size_t)l * 1024 * N, dst + (size_t)l * 1024 * N, 1024, N, kt * 64, nt * 64, sf);
}

DI void phase0(const Params& p, unsigned char* smem) {
  const int tid = tid_opaque(), bid = blockIdx.x, nb = gridDim.x;
  float* sf = (float*)smem;
  if (bid == 0 && tid < 8) wsp<int>(p, OFF_CTR)[tid] = 0;
  for (int i = tid; i < 3072; i += 256) {
    int r = i >> 10, k = i & 1023;
    float c = (r == 0) ? p.in[5][k] : p.in[4][(r - 1) * 1024 + k];
    sf[i] = c * sigmoid_f(c);
  }
  __syncthreads();
  for (int item = bid; item < 384; item += nb) {
    const int l = item / 192, n0 = (item % 192) * 32, col = tid & 31, kg = tid >> 5;
    float a0 = 0.f, a1 = 0.f, a2 = 0.f;
    const float* wm = p.in[6] + (size_t)l * 1024 * 6144 + n0 + col;
    for (int k0 = kg * 128; k0 < kg * 128 + 128; k0 += 16) {
      float w[16];
#pragma unroll
      for (int j = 0; j < 16; ++j) w[j] = wm[(size_t)(k0 + j) * 6144];
#pragma unroll
      for (int j = 0; j < 16; ++j) { a0 += sf[k0 + j] * w[j]; a1 += sf[1024 + k0 + j] * w[j]; a2 += sf[2048 + k0 + j] * w[j]; }
    }
    float* red = sf + 3072;
    red[(kg * 3 + 0) * 32 + col] = a0; red[(kg * 3 + 1) * 32 + col] = a1; red[(kg * 3 + 2) * 32 + col] = a2;
    __syncthreads();
    if (tid < 96) {
      int r = tid >> 5, c = tid & 31;
      float s = 0.f;
#pragma unroll
      for (int g = 0; g < 8; ++g) s += red[(g * 3 + r) * 32 + c];
      wsp<float>(p, OFF_MOD)[(size_t)(l * 3 + r) * 6144 + n0 + c] = s + p.in[7][l * 6144 + n0 + c];
    }
    __syncthreads();
  }
  __syncthreads();
  for (int item = bid; item < 640; item += nb) transpose_item(p, item, sf);
  convert_range(p.in[27], wsp<u16>(p, OFF_WQB), (size_t)2 * 1024 * 2048 / 8);
  convert_range(p.in[28], wsp<u16>(p, OFF_SUBK), (size_t)2 * 2 * 128 * 128 / 8);
  convert_range(p.in[24], wsp<u16>(p, OFF_GWS), (size_t)2 * 4 * 128 * 128 / 8);
  {
    size_t stride = (size_t)nb * 256;
    for (size_t i = (size_t)bid * 256 + tid; i < 262144; i += stride) {
      int d = i & 63, m = (i >> 6) & 255, bl_h = (int)(i >> 14);
      int blv = bl_h >> 2, hh = bl_h & 3;
      size_t sk = ((((size_t)blv * 2 + 0) * 4 + hh) * 256 + m) * 64 + d;
      size_t sv = ((((size_t)blv * 2 + 1) * 4 + hh) * 256 + m) * 64 + d;
      size_t dv = ((size_t)bl_h * 64 + d) * 256 + m;
      wsp<u16>(p, OFF_CKNA)[i] = (u16)f2bf(p.in[2][sk]);
      wsp<u16>(p, OFF_CVNA)[dv] = (u16)f2bf(p.in[2][sv]);
      wsp<u16>(p, OFF_CKD)[i] = (u16)f2bf(p.in[3][sk]);
      wsp<u16>(p, OFF_CVD)[dv] = (u16)f2bf(p.in[3][sv]);
    }
  }
  if (bid == (nb > 1 ? 1 : 0)) {
    for (int i = tid; i < 512; i += 256) {
      int pos = i >> 3, k = i & 7;
      const float invs[8] = {1.0f, 0.31622776601683794f, 0.1f, 0.031622776601683794f, 0.01f, 0.0031622776601683794f, 0.001f, 0.00031622776601683794f};
      float inv = invs[0];
#pragma unroll
      for (int q = 1; q < 8; ++q) inv = (k == q) ? invs[q] : inv;
      float ang = (float)pos * inv;
      float rev = ang * 0.15915494309189535f;
      rev = rev - floorf(rev);
      wsp<float>(p, OFF_ROPE)[i * 2 + 0] = __builtin_amdgcn_cosf(rev);
      wsp<float>(p, OFF_ROPE)[i * 2 + 1] = __builtin_amdgcn_sinf(rev);
    }
  }
}

DI void phase_norm(const Params& p, int l, int which) {
  const int tid = tid_opaque(), lane = tid & 63;
  const int gw = blockIdx.x * 4 + (tid >> 6), nw = gridDim.x * 4;
  const float* gam = p.in[which == 0 ? 8 : 9] + l * 1024;
  u16* H = wsp<u16>(p, OFF_H);
  for (int tb = gw; tb < T; tb += nw * 4) {
    float4 v[4][4];
    float ss[4];
#pragma unroll
    for (int u = 0; u < 4; ++u) {
      const int t = tb + u * nw;
      if (t < T) {
        const float* xr = (which == 0) ? xin_row(p, l, t) : wsp<float>(p, OFF_XMID) + (size_t)t * 1024;
#pragma unroll
        for (int i = 0; i < 4; ++i) v[u][i] = *(const float4*)(xr + i * 256 + lane * 4);
      } else {
#pragma unroll
        for (int i = 0; i < 4; ++i) v[u][i] = make_float4(0.f, 0.f, 0.f, 0.f);
      }
    }
#pragma unroll
    for (int u = 0; u < 4; ++u) {
      float s = 0.f;
#pragma unroll
      for (int i = 0; i < 4; ++i) s += v[u][i].x * v[u][i].x + v[u][i].y * v[u][i].y + v[u][i].z * v[u][i].z + v[u][i].w * v[u][i].w;
      ss[u] = wave_sum(s);
    }
#pragma unroll
    for (int u = 0; u < 4; ++u) {
      const int t = tb + u * nw;
      if (t < T) {
        const float* md = wsp<float>(p, OFF_MOD) + (size_t)(l * 3 + mod_row(t)) * 6144 + (which == 0 ? 0 : 3072);
        const float rs = rsqrtf(ss[u] * (1.f / 1024.f) + EPS);
#pragma unroll
        for (int i = 0; i < 4; ++i) {
          int n = i * 256 + lane * 4;
          float4 g = *(const float4*)(gam + n), sh = *(const float4*)(md + n), sc = *(const float4*)(md + 1024 + n);
          float o0 = v[u][i].x * rs * g.x * (1.f + sc.x) + sh.x;
          float o1 = v[u][i].y * rs * g.y * (1.f + sc.y) + sh.y;
          float o2 = v[u][i].z * rs * g.z * (1.f + sc.z) + sh.z;
          float o3 = v[u][i].w * rs * g.w * (1.f + sc.w) + sh.w;
          u32x2 o; o[0] = pack2(o0, o1); o[1] = pack2(o2, o3);
          *(u32x2*)(H + (size_t)t * 1024 + n) = o;
        }
      }
    }
  }
}

struct GemmPre { u32x4 ra[4], rb[4]; };
DI void gemm_prefetch(const int tid, const u16* A, const u16* Bt, int K, int m0, int n0, GemmPre& pre) {
  const int lrow = tid >> 3, lkc = (tid & 7) * 8;
  const u16* ag = A + (size_t)(m0 + lrow) * K + lkc;
  const u16* bg = Bt + (size_t)(n0 + lrow) * K + lkc;
#pragma unroll
  for (int i = 0; i < 4; ++i) { pre.ra[i] = *(const u32x4*)(ag + (size_t)i * 32 * K); pre.rb[i] = *(const u32x4*)(bg + (size_t)i * 32 * K); }
}
template <bool PRE = false>
DI void gemm_main(const int tid, const u16* A, const u16* Bt, int K, int m0, int n0, u16* sm, f32x16 (&acc)[2][2], int lda = 0, int ldb = 0, const GemmPre* pre = nullptr) {
  if (lda == 0) lda = K;
  if (ldb == 0) ldb = K;
  const int lane = tid & 63, w = tid >> 6, r = lane & 31, h = lane >> 5;
  const int wm = w >> 1, wn = w & 1;
  const int lrow = tid >> 3, lkc = (tid & 7) * 8;
  const u16* ag = A + (size_t)(m0 + lrow) * lda + lkc;
  const u16* bg = Bt + (size_t)(n0 + lrow) * ldb + lkc;
  u32x4 ra[4], rb[4];
#pragma unroll
  for (int a = 0; a < 2; ++a)
#pragma unroll
    for (int b = 0; b < 2; ++b)
#pragma unroll
      for (int i = 0; i < 16; ++i) acc[a][b][i] = 0.f;
  __syncthreads();
  if (PRE) {
#pragma unroll
    for (int i = 0; i < 4; ++i) { ra[i] = pre->ra[i]; rb[i] = pre->rb[i]; }
  } else {
#pragma unroll
    for (int i = 0; i < 4; ++i) { ra[i] = *(const u32x4*)(ag + (size_t)i * 32 * lda); rb[i] = *(const u32x4*)(bg + (size_t)i * 32 * ldb); }
  }
#pragma unroll
  for (int i = 0; i < 4; ++i) {
    *(u32x4*)(sm + (lrow + 32 * i) * 72 + lkc) = ra[i];
    *(u32x4*)(sm + 9216 + (lrow + 32 * i) * 72 + lkc) = rb[i];
  }
  __syncthreads();
  const int nk = K >> 6;
#pragma nounroll
  for (int kt = 0; kt < nk; ++kt) {
    const bool more = (kt + 1 < nk);
    if (more) {
#pragma unroll
      for (int i = 0; i < 4; ++i) {
        ra[i] = *(const u32x4*)(ag + (size_t)i * 32 * lda + (kt + 1) * 64);
        rb[i] = *(const u32x4*)(bg + (size_t)i * 32 * ldb + (kt + 1) * 64);
      }
    }
    const u16* sa = sm + (kt & 1) * 18432;
    const u16* sb = sa + 9216;
    {
      bf16x8 af[4][2], bfr[4][2];
#pragma unroll
      for (int ks = 0; ks < 4; ++ks) {
#pragma unroll
        for (int mt = 0; mt < 2; ++mt) af[ks][mt] = *(const bf16x8*)(sa + (wm * 64 + mt * 32 + r) * 72 + ks * 16 + 8 * h);
#pragma unroll
        for (int nt = 0; nt < 2; ++nt) bfr[ks][nt] = *(const bf16x8*)(sb + (wn * 64 + nt * 32 + r) * 72 + ks * 16 + 8 * h);
      }
      __builtin_amdgcn_sched_barrier(0);
#pragma unroll
      for (int ks = 0; ks < 4; ++ks)
#pragma unroll
        for (int mt = 0; mt < 2; ++mt)
#pragma unroll
          for (int nt = 0; nt < 2; ++nt) acc[mt][nt] = MFMA32(af[ks][mt], bfr[ks][nt], acc[mt][nt]);
      __builtin_amdgcn_sched_barrier(0);
    }
    if (more) {
      u16* da = sm + ((kt + 1) & 1) * 18432;
#pragma unroll
      for (int i = 0; i < 4; ++i) {
        *(u32x4*)(da + (lrow + 32 * i) * 72 + lkc) = ra[i];
        *(u32x4*)(da + 9216 + (lrow + 32 * i) * 72 + lkc) = rb[i];
      }
    }
    __syncthreads();
  }
}

template <int STRIDE = 129>
DI void acc_to_lds(const int tid, const f32x16 (&acc)[2][2], float* Ct) {
  const int lane = tid & 63, w = tid >> 6, r = lane & 31, h = lane >> 5;
  const int wm = w >> 1, wn = w & 1;
#pragma unroll
  for (int mt = 0; mt < 2; ++mt)
#pragma unroll
    for (int nt = 0; nt < 2; ++nt)
#pragma unroll
      for (int i = 0; i < 16; ++i) Ct[(wm * 64 + mt * 32 + crow(i, h)) * STRIDE + wn * 64 + nt * 32 + r] = acc[mt][nt][i];
}

DI void fusedwq_item(const Params& p, int item, unsigned char* smem) {
  const int tid = tid_opaque();
  const int l = item >> 7, hp = (item >> 3) & 15, dc = item & 7;
  const u16* A = wsp<u16>(p, OFF_SUBK) + (size_t)(l * 2 + (hp & 1)) * 128 * 128;
  const u16* Bt = wsp<u16>(p, OFF_WQB) + (size_t)l * 1024 * 2048 + hp * 128;
  f32x16 acc[2][2];
  gemm_main(tid, A, Bt, 128, 0, dc * 128, (u16*)smem, acc, 128, 2048);
  acc_to_lds<132>(tid, acc, (float*)smem);
  __syncthreads();
  const float* Ct = (const float*)smem;
  u16* dst = wsp<u16>(p, OFF_WTQ) + (size_t)l * 2048 * 1024 + (size_t)(hp * 128) * 1024 + dc * 128;
  const int c = (tid & 31) * 4;
#pragma unroll
  for (int it = 0; it < 16; ++it) {
    const int row = it * 8 + (tid >> 5);
    const float4 cv = *(const float4*)(Ct + row * 132 + c);
    u32x2 o; o[0] = pack2(cv.x, cv.y); o[1] = pack2(cv.z, cv.w);
    *(u32x2*)(dst + (size_t)row * 1024 + c) = o;
  }
  __syncthreads();
}

DI void epi_proj(const int tid, const Params& p, int l, int m0, int ntile, const float* Ct) {
  const int row = tid >> 1, ch = tid & 1;
  const int t = m0 + row;
  const int seg = ntile >> 1, half = ntile & 1;
  const float* cr = Ct + row * 129 + ch * 64;
  const int path = (t >= TP) ? 1 : 0;
  int b, pos, L;
  if (!path) { b = t >> 8; pos = t & 255; L = 256; } else { b = (t - TP) >> 12; pos = (t - TP) & 4095; L = 4096; }
  const int head = half * 2 + ch;
  const int cs = half * 128 + ch * 64;
  const size_t pbase = (size_t)path * 2097152;
  const size_t hm = pbase + ((size_t)(b * 4 + head) * L + pos) * 64;
  const size_t vt = pbase + ((size_t)(b * 4 + head) * 64) * L + pos;
  if (seg == 0 || seg == 1) {
    u16* dst = wsp<u16>(p, seg == 0 ? OFF_CONVA : OFF_CONVG) + (size_t)t * 256 + cs;
#pragma unroll
    for (int c8 = 0; c8 < 8; ++c8) { float v[8];
#pragma unroll
      for (int j = 0; j < 8; ++j) v[j] = cr[c8 * 8 + j];
      st8(dst + c8 * 8, v); }
  } else if (seg == 8 || seg == 9) {
    u16* dst = wsp<u16>(p, seg == 8 ? OFF_GU : OFF_GV) + (size_t)t * 256 + cs;
#pragma unroll
    for (int c8 = 0; c8 < 8; ++c8) { float v[8];
#pragma unroll
      for (int j = 0; j < 8; ++j) v[j] = gelu_f(cr[c8 * 8 + j]);
      st8(dst + c8 * 8, v); }
  } else if (seg == 2 || seg == 3) {
    float ss = 0.f;
#pragma unroll
    for (int j = 0; j < 64; ++j) ss += cr[j] * cr[j];
    const float rs = rsqrtf(ss * (1.f / 64.f) + EPS);
    const float* g = p.in[seg == 2 ? 15 : 16] + l * 64;
    u16* dst = wsp<u16>(p, seg == 2 ? OFF_QNA : OFF_KNA) + hm;
    float* okv = p.out + OUT_NAKV + (((((size_t)b * 2 + l) * 2 + 0) * 4 + head) * 256 + pos) * 64;
    const bool wkv = (seg == 3) && !path;
#pragma unroll
    for (int c8 = 0; c8 < 8; ++c8) { float v[8];
#pragma unroll
      for (int j = 0; j < 8; ++j) v[j] = cr[c8 * 8 + j] * rs * g[c8 * 8 + j];
      st8(dst + c8 * 8, v);
      if (wkv) { *(float4*)(okv + c8 * 8) = make_float4(v[0], v[1], v[2], v[3]); *(float4*)(okv + c8 * 8 + 4) = make_float4(v[4], v[5], v[6], v[7]); } }
  } else if (seg == 4 || seg == 7) {
    u16* dst = wsp<u16>(p, seg == 4 ? OFF_VNAT : OFF_VDT) + vt;
    float* okv = p.out + (seg == 4 ? OUT_NAKV : OUT_DKV) + (((((size_t)b * 2 + l) * 2 + 1) * 4 + head) * 256 + pos) * 64;
#pragma unroll
    for (int c8 = 0; c8 < 8; ++c8) { float v[8];
#pragma unroll
      for (int j = 0; j < 8; ++j) { v[j] = cr[c8 * 8 + j]; dst[(size_t)(c8 * 8 + j) * L] = (u16)f2bf(v[j]); }
      if (!path) { *(float4*)(okv + c8 * 8) = make_float4(v[0], v[1], v[2], v[3]); *(float4*)(okv + c8 * 8 + 4) = make_float4(v[4], v[5], v[6], v[7]); } }
  } else {
    const float* g = p.in[seg == 5 ? 18 : 19] + l * 32;
    u16* dst = wsp<u16>(p, seg == 5 ? OFF_QD : OFF_KD) + hm;
    float* okv = p.out + OUT_DKV + (((((size_t)b * 2 + l) * 2 + 0) * 4 + head) * 256 + pos) * 64;
    const bool wkv = (seg == 6) && !path;
    const float* rope = wsp<float>(p, OFF_ROPE);
    const int grow = pos >> 6, gcol = pos & 63;
#pragma unroll
    for (int sub = 0; sub < 2; ++sub) {
      float ss = 0.f;
#pragma unroll
      for (int j = 0; j < 32; ++j) ss += cr[sub * 32 + j] * cr[sub * 32 + j];
      const float rs = rsqrtf(ss * (1.f / 32.f) + EPS);
#pragma unroll
      for (int ps = 0; ps < 2; ++ps) {
        float x1[8], x2[8];
#pragma unroll
        for (int i = 0; i < 8; ++i) {
          x1[i] = cr[sub * 32 + ps * 16 + i] * rs * g[ps * 16 + i];
          x2[i] = cr[sub * 32 + ps * 16 + 8 + i] * rs * g[ps * 16 + 8 + i];
        }
        if (wkv) {
          float* o = okv + sub * 32 + ps * 16;
          *(float4*)(o) = make_float4(x1[0], x1[1], x1[2], x1[3]); *(float4*)(o + 4) = make_float4(x1[4], x1[5], x1[6], x1[7]);
          *(float4*)(o + 8) = make_float4(x2[0], x2[1], x2[2], x2[3]); *(float4*)(o + 12) = make_float4(x2[4], x2[5], x2[6], x2[7]);
        }
        if (path) {
          const float* rp = rope + (size_t)((ps == 0 ? grow : gcol) * 8) * 2;
#pragma unroll
          for (int i = 0; i < 8; ++i) {
            float c = rp[i * 2], s = rp[i * 2 + 1];
            float a1 = x1[i] * c - x2[i] * s, a2 = x1[i] * s + x2[i] * c;
            x1[i] = a1; x2[i] = a2;
          }
        }
        st8(dst + sub * 32 + ps * 16, x1);
        st8(dst + sub * 32 + ps * 16 + 8, x2);
      }
    }
  }
}

DI void phase_proj(const Params& p, int l, unsigned char* smem) {
  const int tid = tid_opaque();
  const u16* A = wsp<u16>(p, OFF_H);
  const u16* Bt = wsp<u16>(p, OFF_WTIN) + (size_t)l * 2560 * 1024;
  GemmPre pre;
  gemm_prefetch(tid, A, Bt, 1024, ((int)blockIdx.x / 20) * 128, ((int)blockIdx.x % 20) * 128, pre);
  for (int tile = blockIdx.x; tile < 128 * 20; tile += gridDim.x) {
    int mt = tile / 20, nt = tile % 20;
    f32x16 acc[2][2];
    gemm_main<true>(tid, A, Bt, 1024, mt * 128, nt * 128, (u16*)smem, acc, 0, 0, &pre);
    { const int nx = tile + gridDim.x; if (nx < 128 * 20) gemm_prefetch(tid, A, Bt, 1024, (nx / 20) * 128, (nx % 20) * 128, pre); }
    acc_to_lds(tid, acc, (float*)smem);
    __syncthreads();
    epi_proj(tid, p, l, mt * 128, nt, (const float*)smem);
#if PROBE_EPI2 > 1
    asm volatile("" ::: "memory");
    epi_proj(tid, p, l, mt * 128, nt, (const float*)smem);
#endif
  }
}

template <int MODE>
DI void attn_item(const Params& p, int l, int item, unsigned char* smem) {
  constexpr bool LAT = (MODE == 1 || MODE == 3);
  constexpr bool DIFF = (MODE >= 2);
  constexpr int NS = DIFF ? 2 : 1;
  const int tid = tid_opaque(), lane = tid & 63, w = tid >> 6, r = lane & 31, h = lane >> 5;
  u16* sKV = (u16*)smem;
  float* sBias = (float*)(smem + 36864);
  u16* sO = (u16*)(smem + 36864 + 2048) + w * 32 * 72;
  int bh, L, path, qpos0;
  if (LAT) { bh = item >> 5; qpos0 = (item & 31) * 128; L = 4096; path = 1; }
  else { bh = item >> 1; qpos0 = (item & 1) * 128; L = 256; path = 0; }
  const int b = bh >> 2, hd = bh & 3;
  const size_t pbase = (size_t)path * 2097152;
  const u16* Qb = wsp<u16>(p, DIFF ? OFF_QD : OFF_QNA) + pbase + ((size_t)bh * L) * 64;
  const u16* Kb = wsp<u16>(p, DIFF ? OFF_KD : OFF_KNA) + pbase + ((size_t)bh * L) * 64;
  const u16* Vb = wsp<u16>(p, DIFF ? OFF_VDT : OFF_VNAT) + pbase + (size_t)bh * 64 * L;
  const u16* CK = wsp<u16>(p, DIFF ? OFF_CKD : OFF_CKNA) + ((size_t)((b * 2 + l) * 4 + hd) * 256) * 64;
  const u16* CV = wsp<u16>(p, DIFF ? OFF_CVD : OFF_CVNA) + ((size_t)((b * 2 + l) * 4 + hd) * 64) * 256;
  const int qpos = qpos0 + w * 32 + r;
  bf16x8 qf[4];
#pragma unroll
  for (int ks = 0; ks < 4; ++ks) qf[ks] = *(const bf16x8*)(Qb + (size_t)qpos * 64 + ks * 16 + 8 * h);
  const int qr = qpos >> 6, qc = qpos & 63;
  const int r0q = clampi(qr - 4, 0, 56), c0q = clampi(qc - 8, 0, 48);
  int rlo = 0, nloc = L / 64;
  if (MODE == 1) { int ra = qpos0 >> 6; rlo = clampi(ra - 4, 0, 56); int rhi = clampi(ra + 1 - 4, 0, 56) + 7; nloc = rhi - rlo + 1; }
  const int nctx = LAT ? 4 : 0;
  const int ntiles = nctx + nloc;
  const float scale = DIFF ? 0.17677669529663687f : 0.125f;
  if (MODE == 1) { for (int i = tid; i < 465; i += 256) sBias[i] = p.in[17][(size_t)(l * 4 + hd) * 465 + i]; }

  u32x4 rk[2], rv[2];
  auto gl = [&](int ti) {
    const u16* ks_; const u16* vs_; int vstr;
    if (LAT && ti < 4) { ks_ = CK + (size_t)ti * 64 * 64; vs_ = CV + ti * 64; vstr = 256; }
    else { int j = ti - nctx; int kp = (MODE == 1) ? (rlo + j) * 64 : j * 64; ks_ = Kb + (size_t)kp * 64; vs_ = Vb + kp; vstr = L; }
#pragma unroll
    for (int i = 0; i < 2; ++i) {
      int c = tid + 256 * i;
      rk[i] = *(const u32x4*)(ks_ + c * 8);
      rv[i] = *(const u32x4*)(vs_ + (size_t)(c >> 3) * vstr + (c & 7) * 8);
    }
  };
  f32x16 o[NS][2];
  float m_[NS], l_[NS];
#pragma unroll
  for (int s = 0; s < NS; ++s) { m_[s] = -1e30f; l_[s] = 0.f;
#pragma unroll
    for (int dt = 0; dt < 2; ++dt)
#pragma unroll
      for (int i = 0; i < 16; ++i) o[s][dt][i] = 0.f; }

  gl(0);
  __syncthreads();
#pragma unroll
  for (int i = 0; i < 2; ++i) {
    int c = tid + 256 * i;
    *(u32x4*)(sKV + (c >> 3) * 72 + (c & 7) * 8) = rk[i];
    *(u32x4*)(sKV + 4608 + (c >> 3) * 72 + (c & 7) * 8) = rv[i];
  }
  if (ntiles > 1) gl(1);
  __syncthreads();
#pragma nounroll
  for (int ti = 0; ti < ntiles; ++ti) {
    const u16* sK = sKV + (ti & 1) * 9216;
    const u16* sV = sK + 4608;
    if (ti + 1 < ntiles) {
      u16* nK = sKV + ((ti + 1) & 1) * 9216;
#pragma unroll
      for (int i = 0; i < 2; ++i) {
        int c = tid + 256 * i;
        *(u32x4*)(nK + (c >> 3) * 72 + (c & 7) * 8) = rk[i];
        *(u32x4*)(nK + 4608 + (c >> 3) * 72 + (c & 7) * 8) = rv[i];
      }
    }
    if (ti + 2 < ntiles) gl(ti + 2);
    const bool local = (ti >= nctx);
    const int kr = rlo + (ti - nctx);
#pragma unroll
    for (int s = 0; s < NS; ++s) {
      f32x16 sc[2];
#pragma unroll
      for (int kt2 = 0; kt2 < 2; ++kt2) {
#pragma unroll
        for (int i = 0; i < 16; ++i) sc[kt2][i] = 0.f;
        if (!DIFF) {
#pragma unroll
          for (int ks = 0; ks < 4; ++ks) {
            bf16x8 a = *(const bf16x8*)(sK + (kt2 * 32 + r) * 72 + ks * 16 + 8 * h);
            sc[kt2] = MFMA32(a, qf[ks], sc[kt2]);
          }
        } else {
#pragma unroll
          for (int ks = 0; ks < 2; ++ks) {
            bf16x8 a = *(const bf16x8*)(sK + (kt2 * 32 + r) * 72 + (s * 2 + ks) * 16 + 8 * h);
            sc[kt2] = MFMA32(a, qf[s * 2 + ks], sc[kt2]);
          }
        }
      }
      constexpr float KSC = (DIFF ? 0.17677669529663687f : 0.125f) * 1.4426950408889634f;
      float mx = -INFINITY;
      if (MODE == 1) {
#pragma unroll
        for (int kt2 = 0; kt2 < 2; ++kt2)
#pragma unroll
          for (int i = 0; i < 16; ++i) {
            float v = sc[kt2][i] * KSC;
            if (local) {
              int kc = kt2 * 32 + crow(i, h);
              bool valid = (kr >= r0q) && (kr < r0q + 8) && (kc >= c0q) && (kc < c0q + 16);
              int bi = valid ? ((kr - qr + 7) * 31 + (kc - qc + 15)) : 0;
              float bv = sBias[bi];
              v = valid ? v + bv * 1.4426950408889634f : -INFINITY;
            }
            sc[kt2][i] = v;
            mx = fmaxf(mx, v);
          }
      } else {
#pragma unroll
        for (int kt2 = 0; kt2 < 2; ++kt2)
#pragma unroll
          for (int i = 0; i < 16; ++i) mx = fmaxf(mx, sc[kt2][i]);
        mx *= KSC;
      }
      mx = fmaxf(mx, __shfl_xor(mx, 32));
      const float mn = fmaxf(m_[s], mx);
      const float alpha = __builtin_amdgcn_exp2f(m_[s] - mn);
      const bool resc = (mn != m_[s]);
      m_[s] = mn;
      float ls = 0.f;
      if (MODE == 1) {
#pragma unroll
        for (int kt2 = 0; kt2 < 2; ++kt2)
#pragma unroll
          for (int i = 0; i < 16; ++i) { float e = __builtin_amdgcn_exp2f(sc[kt2][i] - mn); sc[kt2][i] = e; ls += e; }
      } else {
        f32x2_t ls2 = {0.f, 0.f};
        const f32x2_t k2 = {KSC, KSC}, mn2 = {-mn, -mn};
#pragma unroll
        for (int kt2 = 0; kt2 < 2; ++kt2)
#pragma unroll
          for (int i = 0; i < 16; i += 2) {
            f32x2_t a = {sc[kt2][i], sc[kt2][i + 1]};
            a = __builtin_elementwise_fma(a, k2, mn2);
            f32x2_t e = {__builtin_amdgcn_exp2f(a[0]), __builtin_amdgcn_exp2f(a[1])};
            sc[kt2][i] = e[0]; sc[kt2][i + 1] = e[1];
            ls2 += e;
          }
        ls = ls2[0] + ls2[1];
      }
      l_[s] = l_[s] * alpha + ls;
      if (__any(resc)) {
#pragma unroll
        for (int dt = 0; dt < 2; ++dt)
#pragma unroll
          for (int i = 0; i < 16; ++i) o[s][dt][i] *= alpha;
      }
#pragma unroll
      for (int kt2 = 0; kt2 < 2; ++kt2)
#pragma unroll
        for (int st = 0; st < 2; ++st) {
          u32x4 pk;
#pragma unroll
          for (int j = 0; j < 4; ++j) pk[j] = pack2(sc[kt2][8 * st + 2 * j], sc[kt2][8 * st + 2 * j + 1]);
          bf16x8 pf = __builtin_bit_cast(bf16x8, pk);
          const int koff = kt2 * 32 + 16 * st + 4 * h;
#pragma unroll
          for (int dt = 0; dt < 2; ++dt) {
            u32x2 lo = *(const u32x2*)(sV + (dt * 32 + r) * 72 + koff);
            u32x2 hi = *(const u32x2*)(sV + (dt * 32 + r) * 72 + koff + 8);
            u32x4 vv; vv[0] = lo[0]; vv[1] = lo[1]; vv[2] = hi[0]; vv[3] = hi[1];
            o[s][dt] = MFMA32(__builtin_bit_cast(bf16x8, vv), pf, o[s][dt]);
          }
        }
    }
    __syncthreads();
  }
  float inv[NS];
#pragma unroll
  for (int s = 0; s < NS; ++s) { float lt = l_[s] + __shfl_xor(l_[s], 32); inv[s] = 1.f / lt; }
  if (!DIFF) {
#pragma unroll
    for (int dt = 0; dt < 2; ++dt)
#pragma unroll
      for (int i = 0; i < 16; ++i) sO[r * 72 + dt * 32 + crow(i, h)] = (u16)f2bf(o[0][dt][i] * inv[0]);
  } else {
    const float lam_init = 0.8f - 0.6f * __expf(-0.3f * (float)l);
    const float* dl = p.in[20] + l * 128;
    float s01 = 0.f, s23 = 0.f;
    for (int i = 0; i < 32; ++i) { s01 += dl[i] * dl[32 + i]; s23 += dl[64 + i] * dl[96 + i]; }
    const float lam = __expf(s01) - __expf(s23) + lam_init;
    const float* sg = p.in[21] + l * 64;
    float ss = 0.f;
#pragma unroll
    for (int dt = 0; dt < 2; ++dt)
#pragma unroll
      for (int i = 0; i < 16; ++i) { float v = o[0][dt][i] * inv[0] - lam * o[NS - 1][dt][i] * inv[NS - 1]; o[0][dt][i] = v; ss += v * v; }
    ss += __shfl_xor(ss, 32);
    const float rs = rsqrtf(ss * (1.f / 64.f) + EPS) * (1.f - lam_init);
#pragma unroll
    for (int dt = 0; dt < 2; ++dt)
#pragma unroll
      for (int i = 0; i < 16; ++i) { int d = dt * 32 + crow(i, h); sO[r * 72 + d] = (u16)f2bf(o[0][dt][i] * rs * sg[d]); }
  }
  __syncthreads();
  {
    u16* mix = wsp<u16>(p, OFF_MIX);
    const int tok0 = path * TP + b * L + qpos0 + w * 32;
    const int colb = (DIFF ? 512 : 256) + hd * 64;
#pragma unroll
    for (int i = 0; i < 4; ++i) {
      int c = lane + 64 * i, q = c >> 3, dc = c & 7;
      u32x4 v = *(const u32x4*)(sO + q * 72 + dc * 8);
      *(u32x4*)(mix + (size_t)(tok0 + q) * 1024 + colb + dc * 8) = v;
    }
  }
  __syncthreads();
}

DI void conv_item(const Params& p, int l, int item, unsigned char* smem) {
  const int tid = tid_opaque(), lane = tid & 63, w = tid >> 6;
  float* y = (float*)smem;
  const int t0 = item * 32;
  int L, pos0, tseq0;
  if (t0 < TP) { L = 256; pos0 = t0 & 255; tseq0 = t0 - pos0; } else { L = 4096; pos0 = (t0 - TP) & 4095; tseq0 = t0 - pos0; }
  const u16* ca = wsp<u16>(p, OFF_CONVA);
  const u16* cgp = wsp<u16>(p, OFF_CONVG);
  const int c = tid;
  for (int j = 0; j < 62; ++j) {
    int pos = pos0 - 15 + j;
    float v = 0.f;
    if (pos >= 0 && pos < L) {
      size_t idx = (size_t)(tseq0 + pos) * 256 + c;
      v = bf1(ca[idx]) * sigmoid_f(bf1(cgp[idx]));
    }
    y[j * 256 + c] = v;
  }
  float wv[31];
  const float* cw = p.in[11] + (size_t)l * 31 * 256 + c;
#pragma unroll
  for (int k = 0; k < 31; ++k) wv[k] = cw[k * 256];
  const float bias = p.in[12][l * 256 + c];
  float acc[32];
  __syncthreads();
#pragma unroll
  for (int i = 0; i < 32; ++i) {
    float a = bias;
#pragma unroll
    for (int k = 0; k < 31; ++k) a += y[(i + k) * 256 + c] * wv[k];
    acc[i] = a;
  }
  __syncthreads();
#pragma unroll
  for (int i = 0; i < 32; ++i) y[i * 256 + c] = acc[i];
  __syncthreads();
  const float* lg = p.in[13] + l * 256;
  const float* lb = p.in[14] + l * 256;
  u16* mix = wsp<u16>(p, OFF_MIX);
#pragma nounroll
  for (int ii = 0; ii < 8; ++ii) {
    int i = w * 8 + ii;
    float v[4]; float s = 0.f;
#pragma unroll
    for (int q = 0; q < 4; ++q) { v[q] = y[i * 256 + lane + 64 * q]; s += v[q]; }
    s = wave_sum(s);
    float mu = s * (1.f / 256.f);
    float vs = 0.f;
#pragma unroll
    for (int q = 0; q < 4; ++q) { float d = v[q] - mu; vs += d * d; }
    vs = wave_sum(vs);
    float rs = rsqrtf(vs * (1.f / 256.f) + EPS);
#pragma unroll
    for (int q = 0; q < 4; ++q) {
      int cc = lane + 64 * q;
      float z = (v[q] - mu) * rs * lg[cc] + lb[cc];
      mix[(size_t)(t0 + i) * 1024 + cc] = (u16)f2bf(z * sigmoid_f(z));
    }
  }
  __syncthreads();
}

DI void gmlp_item(const Params& p, int l, int item, unsigned char* smem) {
  const int tid = tid_opaque(), lane = tid & 63, w = tid >> 6, r = lane & 31, h = lane >> 5;
  const int n = item >> 2, g = item & 3;
  const int t0 = n * 128;
  u16* vnT = (u16*)smem;
  float* smu = (float*)(smem + 17408);
  float* srs = smu + 128;
  const u16* gv = wsp<u16>(p, OFF_GV);
  const u16* gu = wsp<u16>(p, OFF_GU);
  if (tid < 128) {
    const u16* rowp = gv + (size_t)(t0 + tid) * 256;
    float s = 0.f;
    for (int q = 0; q < 32; ++q) {
      u32x4 v = *(const u32x4*)(rowp + q * 8);
#pragma unroll
      for (int j = 0; j < 4; ++j) s += bf_lo(v[j]) + bf_hi(v[j]);
    }
    float mu = s * (1.f / 256.f);
    float vs = 0.f;
    for (int q = 0; q < 32; ++q) {
      u32x4 v = *(const u32x4*)(rowp + q * 8);
#pragma unroll
      for (int j = 0; j < 4; ++j) { float a = bf_lo(v[j]) - mu, bq = bf_hi(v[j]) - mu; vs += a * a + bq * bq; }
    }
    smu[tid] = mu; srs[tid] = rsqrtf(vs * (1.f / 256.f) + EPS);
  }
  __syncthreads();
  {
    const int j = tid & 127, chalf = tid >> 7;
    const float mu = smu[j], rs = srs[j];
    const u16* rowp = gv + (size_t)(t0 + j) * 256 + g * 64 + chalf * 32;
    const float* lg = p.in[22] + l * 256 + g * 64 + chalf * 32;
    const float* lb = p.in[23] + l * 256 + g * 64 + chalf * 32;
#pragma unroll
    for (int q = 0; q < 4; ++q) {
      u32x4 v = *(const u32x4*)(rowp + q * 8);
#pragma unroll
      for (int jj = 0; jj < 4; ++jj) {
        int c0 = q * 8 + jj * 2;
        float a = (bf_lo(v[jj]) - mu) * rs * lg[c0] + lb[c0];
        float bq = (bf_hi(v[jj]) - mu) * rs * lg[c0 + 1] + lb[c0 + 1];
        vnT[(chalf * 32 + c0) * 136 + j] = (u16)f2bf(a);
        vnT[(chalf * 32 + c0 + 1) * 136 + j] = (u16)f2bf(bq);
      }
    }
  }
  __syncthreads();
  f32x16 acc[2];
#pragma unroll
  for (int nt = 0; nt < 2; ++nt)
#pragma unroll
    for (int i = 0; i < 16; ++i) acc[nt][i] = 0.f;
  const u16* wsg = wsp<u16>(p, OFF_GWS) + ((size_t)(l * 4 + g) * 128 + w * 32 + r) * 128;
#pragma unroll
  for (int ks = 0; ks < 8; ++ks) {
    bf16x8 a = *(const bf16x8*)(wsg + ks * 16 + 8 * h);
#pragma unroll
    for (int nt = 0; nt < 2; ++nt) {
      bf16x8 bq = *(const bf16x8*)(vnT + (nt * 32 + r) * 136 + ks * 16 + 8 * h);
      acc[nt] = MFMA32(a, bq, acc[nt]);
    }
  }
  const float* bs = p.in[25] + (size_t)(l * 4 + g) * 128;
  u16* mix = wsp<u16>(p, OFF_MIX);
#pragma unroll
  for (int nt = 0; nt < 2; ++nt)
#pragma unroll
    for (int i = 0; i < 16; ++i) {
      int ir = w * 32 + crow(i, h), cc = nt * 32 + r;
      float u = bf1(gu[(size_t)(t0 + ir) * 256 + g * 64 + cc]);
      mix[(size_t)(t0 + ir) * 1024 + 768 + g * 64 + cc] = (u16)f2bf(u * (acc[nt][i] + bs[ir]));
    }
  __syncthreads();
}

DI void phase_mix(const Params& p, int l, unsigned char* smem, int rep = 0) {
  int* ctr = wsp<int>(p, OFF_CTR) + l + 2 * rep;
  int* sitem = (int*)(smem + SMEM_BYTES - 16);
  while (true) {
    __syncthreads();
    if (threadIdx.x == 0) *sitem = atomicAdd(ctr, 1);
    __syncthreads();
    const int item = *sitem;
    __syncthreads();
    if (item >= (l == 0 ? 3104 : 2560)) break;
    if (item < 256) { if (MIXMASK & 1) attn_item<3>(p, l, item, smem); }
    else if (item < 512) { if (MIXMASK & 2) attn_item<1>(p, l, item - 256, smem); }
    else if (item < 768) { if (MIXMASK & 4) attn_item<2>(p, l, item - 512, smem); }
    else if (item < 1024) { if (MIXMASK & 8) attn_item<0>(p, l, item - 768, smem); }
    else if (item < 1536) { if (MIXMASK & 16) gmlp_item(p, l, item - 1024, smem); }
    else if (item < 2048) { if (MIXMASK & 32) conv_item(p, l, item - 1536, smem); }
    else if (item < 2560) {
      const int q = item - 2048, tab = q >> 8, row0 = l * 16384 + (q & 255) * 64;
      quant_rows64(p.in[tab == 0 ? 29 : 30], p.ws + (tab == 0 ? OFF_PU : OFF_PV), wsp<float>(p, tab == 0 ? OFF_SU : OFF_SV), row0);
    } else if (item < 2816) {
      fusedwq_item(p, item - 2560, smem);
    } else {
#pragma nounroll
      for (int j = 0; j < 4; ++j) {
        const int tt = (item - 2816) * 4 + j;
        const int ti = tt < 512 ? 1280 + tt : 640 + (tt - 512);
        transpose_item(p, ti, (float*)smem);
      }
    }
  }
}

DI void phase_outproj(const Params& p, int l, unsigned char* smem) {
  const int tid = tid_opaque(), lane = tid & 63, w = tid >> 6, r = lane & 31, h = lane >> 5;
  const int wm = w >> 1, wn = w & 1;
  const u16* A = wsp<u16>(p, OFF_MIX);
  const u16* Bt = wsp<u16>(p, OFF_WTOUT) + (size_t)l * 1024 * 1024;
  float* xmid = wsp<float>(p, OFF_XMID);
  GemmPre pre;
  gemm_prefetch(tid, A, Bt, 1024, ((int)blockIdx.x >> 3) * 128, ((int)blockIdx.x & 7) * 128, pre);
  for (int tile = blockIdx.x; tile < 128 * 8; tile += gridDim.x) {
    int mt_ = tile >> 3, nt_ = tile & 7;
    const int m0 = mt_ * 128, n0 = nt_ * 128;
    f32x16 acc[2][2];
    gemm_main<true>(tid, A, Bt, 1024, m0, n0, (u16*)smem, acc, 0, 0, &pre);
    { const int nx = tile + gridDim.x; if (nx < 128 * 8) gemm_prefetch(tid, A, Bt, 1024, (nx >> 3) * 128, (nx & 7) * 128, pre); }
    const float* g1 = wsp<float>(p, OFF_MOD) + (size_t)(l * 3 + mod_row(m0)) * 6144 + 2048;
    acc_to_lds<132>(tid, acc, (float*)smem);
    __syncthreads();
    {
      const float* Ct = (const float*)smem;
      const int c = (tid & 31) * 4;
      const float4 gv = *(const float4*)(g1 + n0 + c);
#pragma unroll
      for (int it = 0; it < 16; ++it) {
        const int row = it * 8 + (tid >> 5), m = m0 + row;
        const float4 cv = *(const float4*)(Ct + row * 132 + c);
        const float4 xv = *(const float4*)(xin_row(p, l, m) + n0 + c);
        *(float4*)(xmid + (size_t)m * 1024 + n0 + c) = make_float4(xv.x + gv.x * cv.x, xv.y + gv.y * cv.y, xv.z + gv.z * cv.z, xv.w + gv.w * cv.w);
      }
    }
  }
}

DI void ins16(float (&Lst)[16], float key) {
#pragma unroll
  for (int j = 15; j >= 1; --j) Lst[j] = __builtin_amdgcn_fmed3f(key, Lst[j - 1], Lst[j]);
  Lst[0] = fmaxf(key, Lst[0]);
}

DI void phase_peerq(const Params& p, int l, unsigned char* smem) {
  const int tid = tid_opaque(), lane = tid & 63, w = tid >> 6, r = lane & 31, h = lane >> 5;
  const int wm = w >> 1, wn = w & 1;
  const u16* A = wsp<u16>(p, OFF_H);
  const u16* Bt = wsp<u16>(p, OFF_WTQ) + (size_t)l * 2048 * 1024;
  u16* sQ = (u16*)smem;
  u16* sS = sQ + 128 * 136;
  float* Ct = (float*)smem;
  u32* tmpl = (u32*)(smem + 66048);
  float* ltmp = wsp<float>(p, OFF_LTMP) + (size_t)blockIdx.x * 4096;
  GemmPre pre;
  gemm_prefetch(tid, A, Bt, 1024, ((int)blockIdx.x >> 3) * 128, (((int)blockIdx.x & 7) * 2) * 128, pre);
  for (int item = blockIdx.x; item < 1024; item += gridDim.x) {
    const int m0 = (item >> 3) * 128, hd = item & 7;
#pragma nounroll
    for (int pp = 0; pp < 2; ++pp) {
      f32x16 acc[2][2];
      gemm_main<true>(tid, A, Bt, 1024, m0, (hd * 2 + pp) * 128, (u16*)smem, acc, 0, 0, &pre);
      {
        const int nitem = pp == 0 ? item : item + (int)gridDim.x, npp = pp ^ 1;
        if (nitem < 1024) gemm_prefetch(tid, A, Bt, 1024, (nitem >> 3) * 128, ((nitem & 7) * 2 + npp) * 128, pre);
      }
      acc_to_lds(tid, acc, Ct);
      __syncthreads();
      const int row = tid & 127, half = tid >> 7;
      float Lc[16];
#pragma unroll
      for (int j = 0; j < 16; ++j) Lc[j] = -INFINITY;
#pragma nounroll
      for (int j0 = 0; j0 < 64; j0 += 8) {
#pragma unroll
        for (int jj = 0; jj < 8; ++jj) {
          int j = j0 + jj;
          float v = Ct[row * 129 + half * 64 + j];
          float key = __uint_as_float((__float_as_uint(v) & 0xffffff80u) | (u32)(half * 64 + j));
          ins16(Lc, key);
        }
      }
      if (half == 1) {
#pragma unroll
        for (int j = 0; j < 16; ++j) tmpl[row * 16 + j] = __float_as_uint(Lc[j]);
      }
      __syncthreads();
      if (half == 0) {
#pragma unroll
        for (int j = 0; j < 16; ++j) ins16(Lc, __uint_as_float(tmpl[row * 16 + j]));
#pragma unroll
        for (int j = 0; j < 16; j += 4) *(float4*)(ltmp + (pp * 128 + row) * 16 + j) = make_float4(Lc[j], Lc[j + 1], Lc[j + 2], Lc[j + 3]);
      }
    }
    __syncthreads();
    u32* lists = (u32*)smem;
    if (tid < 128) {
      const int row = tid;
      float La[16], Lb[16];
#pragma unroll
      for (int j = 0; j < 16; j += 4) { float4 q = *(const float4*)(ltmp + row * 16 + j); La[j] = q.x; La[j + 1] = q.y; La[j + 2] = q.z; La[j + 3] = q.w; }
#pragma unroll
      for (int j = 0; j < 16; j += 4) { float4 q = *(const float4*)(ltmp + (128 + row) * 16 + j); Lb[j] = q.x; Lb[j + 1] = q.y; Lb[j + 2] = q.z; Lb[j + 3] = q.w; }
#pragma unroll
      for (int j = 0; j < 16; ++j) { lists[(row * 2 + 0) * 16 + j] = __float_as_uint(La[j]); lists[(row * 2 + 1) * 16 + j] = __float_as_uint(Lb[j]); }
      float Tl[16];
#pragma unroll
      for (int j = 0; j < 16; ++j) Tl[j] = -INFINITY;
#pragma unroll
      for (int i = 0; i < 16; ++i) {
        const float va = __uint_as_float(__float_as_uint(La[i]) & 0xffffff80u);
#pragma unroll
        for (int j = 0; j < 16; ++j) {
          if ((i + 1) * (j + 1) <= 16) {
            float vb = __uint_as_float(__float_as_uint(Lb[j]) & 0xffffff80u);
            float sum = va + vb;
            float key = __uint_as_float((__float_as_uint(sum) & 0xffffff00u) | (u32)(i * 16 + j));
            ins16(Tl, key);
          }
        }
      }
      float ev[16]; int ei[16];
      float mx = 0.f, den = 0.f;
#pragma unroll
      for (int k = 0; k < 16; ++k) {
        u32 code = __float_as_uint(Tl[k]) & 255u;
        u32 ka = lists[(row * 2 + 0) * 16 + (code >> 4)];
        u32 kb = lists[(row * 2 + 1) * 16 + (code & 15u)];
        float s = __uint_as_float(ka & 0xffffff80u) + __uint_as_float(kb & 0xffffff80u);
        if (k == 0) mx = s;
        float e = __expf(s - mx);
        ev[k] = e; den += e;
        ei[k] = (int)((ka & 127u) * 128u + (kb & 127u));
      }
      const float rden = 1.f / den;
      int* eo = wsp<int>(p, OFF_EIDX) + ((size_t)(m0 + row) * 8 + hd) * 16;
      float* go = wsp<float>(p, OFF_GATE) + ((size_t)(m0 + row) * 8 + hd) * 16;
#pragma unroll
      for (int k = 0; k < 16; k += 4) {
        *(int4*)(eo + k) = make_int4(ei[k], ei[k + 1], ei[k + 2], ei[k + 3]);
        *(float4*)(go + k) = make_float4(ev[k] * rden, ev[k + 1] * rden, ev[k + 2] * rden, ev[k + 3] * rden);
      }
    }
  }
}

typedef float f32x2 __attribute__((ext_vector_type(2)));
typedef _Float16 h2_t __attribute__((ext_vector_type(2)));
DI float dot16f4h(const u32x2& a, const h2_t (&hh)[8]) {
  float s = 0.f;
  s = __builtin_amdgcn_fdot2(__builtin_amdgcn_cvt_scalef32_pk_f16_fp4(a[0], 1.0f, 0), hh[0], s, false);
  s = __builtin_amdgcn_fdot2(__builtin_amdgcn_cvt_scalef32_pk_f16_fp4(a[0], 1.0f, 1), hh[1], s, false);
  s = __builtin_amdgcn_fdot2(__builtin_amdgcn_cvt_scalef32_pk_f16_fp4(a[0], 1.0f, 2), hh[2], s, false);
  s = __builtin_amdgcn_fdot2(__builtin_amdgcn_cvt_scalef32_pk_f16_fp4(a[0], 1.0f, 3), hh[3], s, false);
  s = __builtin_amdgcn_fdot2(__builtin_amdgcn_cvt_scalef32_pk_f16_fp4(a[1], 1.0f, 0), hh[4], s, false);
  s = __builtin_amdgcn_fdot2(__builtin_amdgcn_cvt_scalef32_pk_f16_fp4(a[1], 1.0f, 1), hh[5], s, false);
  s = __builtin_amdgcn_fdot2(__builtin_amdgcn_cvt_scalef32_pk_f16_fp4(a[1], 1.0f, 2), hh[6], s, false);
  s = __builtin_amdgcn_fdot2(__builtin_amdgcn_cvt_scalef32_pk_f16_fp4(a[1], 1.0f, 3), hh[7], s, false);
  return s;
}
DI float dot16f4(const u32x2& a, const float (&hf)[16]) {
  f32x2 s = {0.f, 0.f};
#pragma unroll
  for (int q = 0; q < 2; ++q) {
#pragma unroll
    for (int b = 0; b < 4; ++b) {
      f32x2 e;
      if (b == 0) e = __builtin_amdgcn_cvt_scalef32_pk_f32_fp4(a[q], 1.0f, 0);
      else if (b == 1) e = __builtin_amdgcn_cvt_scalef32_pk_f32_fp4(a[q], 1.0f, 1);
      else if (b == 2) e = __builtin_amdgcn_cvt_scalef32_pk_f32_fp4(a[q], 1.0f, 2);
      else e = __builtin_amdgcn_cvt_scalef32_pk_f32_fp4(a[q], 1.0f, 3);
      f32x2 hv = {hf[8 * q + 2 * b], hf[8 * q + 2 * b + 1]};
      s = __builtin_elementwise_fma(e, hv, s);
    }
  }
  return s[0] + s[1];
}

DI void phase_peer(const Params& p, int l, unsigned char* smem) {
  const int tid = tid_opaque(), lane = tid & 63, w = tid >> 6;
  const int gw = blockIdx.x * 4 + w, nw = gridDim.x * 4;
  const unsigned char* PU = p.ws + OFF_PU + (size_t)l * 16384 * 512;
  const unsigned char* PV = p.ws + OFF_PV + (size_t)l * 16384 * 512;
  const float* SU = wsp<float>(p, OFF_SU) + l * 16384;
  const float* SV = wsp<float>(p, OFF_SV) + l * 16384;
  u16* H = wsp<u16>(p, OFF_H);
  const int* EI = wsp<int>(p, OFF_EIDX);
  const float* GT = wsp<float>(p, OFF_GATE);
  const float* xmid = wsp<float>(p, OFF_XMID);
  float* wbuf = (float*)smem + w * 1024;
  const __amdgpu_buffer_rsrc_t rsU = __builtin_amdgcn_make_buffer_rsrc((void*)PU, (short)0, 16384 * 512, 0x00020000);
  const __amdgpu_buffer_rsrc_t rsV = __builtin_amdgcn_make_buffer_rsrc((void*)PV, (short)0, 16384 * 512, 0x00020000);
  const unsigned loff8 = (unsigned)lane * 8u;
  const bool b0 = lane & 1, b1 = lane & 2, b2 = lane & 4, b3 = lane & 8, b4 = lane & 16;
  const int l31 = lane & 31;
#pragma nounroll
  for (int tb = gw; tb < T; tb += nw * 8) {
#pragma nounroll
    for (int i = 0; i < 8; ++i) {
      const int t = tb + i * nw;
      if (t >= T) break;
      h2_t hf[8];
      {
        u32x4 ha = *(const u32x4*)(H + (size_t)t * 1024 + lane * 16);
        u32x4 hb = *(const u32x4*)(H + (size_t)t * 1024 + lane * 16 + 8);
#pragma unroll
        for (int q = 0; q < 4; ++q) {
          h2_t x = {(_Float16)bf_lo(ha[q]), (_Float16)bf_hi(ha[q])}; hf[q] = x;
          h2_t y = {(_Float16)bf_lo(hb[q]), (_Float16)bf_hi(hb[q])}; hf[4 + q] = y;
        }
      }
      int e8[8];
#pragma unroll
      for (int hd = 0; hd < 8; ++hd) e8[hd] = EI[(size_t)t * 128 + hd * 16 + (lane & 15)];
      u32x2 ruA[16], ruB[16];
#define P1_LOAD(R, HD) { _Pragma("unroll") for (int k = 0; k < 16; ++k) { const int ek = __builtin_amdgcn_readlane(e8[HD], k); R[k] = __builtin_bit_cast(u32x2, __builtin_amdgcn_raw_buffer_load_b64(rsU, (int)loff8, ek * 512, 0)); } }
#define P1_COMP(R, HD) { \
        const float g = GT[(size_t)t * 128 + (HD) * 16 + (lane & 15)]; \
        const float su = SU[e8[HD]], sv = SV[e8[HD]]; \
        float part[16]; \
        _Pragma("unroll") for (int k = 0; k < 16; ++k) part[k] = dot16f4h(R[k], hf); \
        float q8[8], q4[4], q2[2], q1; \
        _Pragma("unroll") for (int j = 0; j < 8; ++j) { float keep = b0 ? part[2 * j + 1] : part[2 * j]; float send = b0 ? part[2 * j] : part[2 * j + 1]; q8[j] = keep + swz_xor(send, 1); } \
        _Pragma("unroll") for (int j = 0; j < 4; ++j) { float keep = b1 ? q8[2 * j + 1] : q8[2 * j]; float send = b1 ? q8[2 * j] : q8[2 * j + 1]; q4[j] = keep + swz_xor(send, 2); } \
        _Pragma("unroll") for (int j = 0; j < 2; ++j) { float keep = b2 ? q4[2 * j + 1] : q4[2 * j]; float send = b2 ? q4[2 * j] : q4[2 * j + 1]; q2[j] = keep + swz_xor(send, 4); } \
        { float keep = b3 ? q2[1] : q2[0]; float send = b3 ? q2[0] : q2[1]; q1 = keep + swz_xor(send, 8); } \
        q1 += swz_xor(q1, 16); \
        q1 += __shfl_xor(q1, 32); \
        const float wgt = gelu_f(q1 * su) * g * sv; \
        if (lane < 16) wbuf[i * 128 + (HD) * 16 + lane] = wgt; }
      P1_LOAD(ruA, 0)
#pragma unroll
      for (int hd = 0; hd < 8; hd += 2) {
        P1_LOAD(ruB, hd + 1)
        P1_COMP(ruA, hd)
        if (hd + 2 < 8) P1_LOAD(ruA, hd + 2)
        P1_COMP(ruB, hd + 1)
      }
#undef P1_LOAD
#undef P1_COMP
    }
#pragma nounroll
    for (int i = 0; i < 8; ++i) {
      const int t = tb + i * nw;
      if (t >= T) break;
      float acc[16];
#pragma unroll
      for (int j = 0; j < 16; ++j) acc[j] = 0.f;
      int e8[8];
#pragma unroll
      for (int hd = 0; hd < 8; ++hd) e8[hd] = EI[(size_t)t * 128 + hd * 16 + (lane & 15)];
      u32x2 rvA[16], rvB[16];
#define P2_LOAD(R, HD) { _Pragma("unroll") for (int k = 0; k < 16; ++k) { const int ek = __builtin_amdgcn_readlane(e8[HD], k); R[k] = __builtin_bit_cast(u32x2, __builtin_amdgcn_raw_buffer_load_b64(rsV, (int)loff8, ek * 512, 0)); } }
#define P2_COMP(R, HD) { \
        const float wgt = wbuf[i * 128 + (HD) * 16 + (lane & 15)]; \
        _Pragma("unroll") for (int k = 0; k < 16; ++k) { \
          const float wk = __uint_as_float(__builtin_amdgcn_readlane(__float_as_uint(wgt), k)); \
          _Pragma("unroll") for (int q = 0; q < 2; ++q) { \
            f32x2 e0 = __builtin_amdgcn_cvt_scalef32_pk_f32_fp4(R[k][q], 1.0f, 0); \
            f32x2 e1 = __builtin_amdgcn_cvt_scalef32_pk_f32_fp4(R[k][q], 1.0f, 1); \
            f32x2 e2 = __builtin_amdgcn_cvt_scalef32_pk_f32_fp4(R[k][q], 1.0f, 2); \
            f32x2 e3 = __builtin_amdgcn_cvt_scalef32_pk_f32_fp4(R[k][q], 1.0f, 3); \
            acc[8 * q] += wk * e0[0]; acc[8 * q + 1] += wk * e0[1]; acc[8 * q + 2] += wk * e1[0]; acc[8 * q + 3] += wk * e1[1]; \
            acc[8 * q + 4] += wk * e2[0]; acc[8 * q + 5] += wk * e2[1]; acc[8 * q + 6] += wk * e3[0]; acc[8 * q + 7] += wk * e3[1]; } } }
      P2_LOAD(rvA, 0)
#pragma unroll
      for (int hd = 0; hd < 8; hd += 2) {
        P2_LOAD(rvB, hd + 1)
        P2_COMP(rvA, hd)
        if (hd + 2 < 8) P2_LOAD(rvA, hd + 2)
        P2_COMP(rvB, hd + 1)
      }
#undef P2_LOAD
#undef P2_COMP
      const float* g2 = wsp<float>(p, OFF_MOD) + (size_t)(l * 3 + mod_row(t)) * 6144 + 5120;
      float* yo = p.out + (size_t)t * 1024;
      const float* xm = xmid + (size_t)t * 1024;
      float ss = 0.f;
#pragma unroll
      for (int q = 0; q < 4; ++q) {
        int n = lane * 16 + q * 4;
        float4 x0 = *(const float4*)(xm + n);
        float4 ga = *(const float4*)(g2 + n);
        acc[4 * q] = x0.x + ga.x * acc[4 * q]; acc[4 * q + 1] = x0.y + ga.y * acc[4 * q + 1];
        acc[4 * q + 2] = x0.z + ga.z * acc[4 * q + 2]; acc[4 * q + 3] = x0.w + ga.w * acc[4 * q + 3];
        *(float4*)(yo + n) = make_float4(acc[4 * q], acc[4 * q + 1], acc[4 * q + 2], acc[4 * q + 3]);
        ss += acc[4 * q] * acc[4 * q] + acc[4 * q + 1] * acc[4 * q + 1] + acc[4 * q + 2] * acc[4 * q + 2] + acc[4 * q + 3] * acc[4 * q + 3];
      }
      if (l == 0) {
        ss = wave_sum(ss);
        const float rs = rsqrtf(ss * (1.f / 1024.f) + EPS);
        const float* gam = p.in[8] + 1024;
        const float* md = wsp<float>(p, OFF_MOD) + (size_t)(3 + mod_row(t)) * 6144;
        float hv[16];
#pragma unroll
        for (int q = 0; q < 4; ++q) {
          int n = lane * 16 + q * 4;
          float4 gg = *(const float4*)(gam + n), sh = *(const float4*)(md + n), sc = *(const float4*)(md + 1024 + n);
          hv[4 * q] = acc[4 * q] * rs * gg.x * (1.f + sc.x) + sh.x; hv[4 * q + 1] = acc[4 * q + 1] * rs * gg.y * (1.f + sc.y) + sh.y;
          hv[4 * q + 2] = acc[4 * q + 2] * rs * gg.z * (1.f + sc.z) + sh.z; hv[4 * q + 3] = acc[4 * q + 3] * rs * gg.w * (1.f + sc.w) + sh.w;
        }
        st8(H + (size_t)t * 1024 + lane * 16, hv);
        st8(H + (size_t)t * 1024 + lane * 16 + 8, hv + 8);
      }
    }
  }
}

#define XB_TMO      128
#define XB_XCNT(j)  (256  + 64 * (j))
#define XB_XSUB(j)  (1280 + 64 * (j))
#define XB_XGEN(j)  (2304 + 64 * (j))
#define XB_TOP      3328
#define XB_TOPGEN   3392
#define XCD_BAR_WORDS 3456
#define XB_SPIN_CAP (1u << 20)
#define LAS __attribute__((address_space(3)))
DI unsigned xb_ld(unsigned* p) { return __hip_atomic_load(p, __ATOMIC_RELAXED, __HIP_MEMORY_SCOPE_AGENT); }
DI unsigned xb_add(unsigned* p, unsigned v) { return __hip_atomic_fetch_add(p, v, __ATOMIC_RELAXED, __HIP_MEMORY_SCOPE_AGENT); }
DI unsigned xb_xcc_id() { return (unsigned)__builtin_amdgcn_s_getreg((3 << 11) | 20) & 0xFu; }
#define XB_SPIN(cond, bar) do { unsigned _sp = 0; while (cond) { __builtin_amdgcn_s_sleep(1); \
    if ((++_sp & 255u) == 0u) { if (xb_ld(&(bar)[XB_TMO])) break; if (_sp > XB_SPIN_CAP) { atomicAdd(&(bar)[XB_TMO], 1u); break; } } } } while (0)
struct XcdBarrier { unsigned* bar; unsigned x; volatile LAS unsigned* st; };
DI XcdBarrier xcd_barrier_post(unsigned* bar, volatile LAS unsigned* st) {
  XcdBarrier b; b.bar = bar; b.x = xb_xcc_id(); b.st = st;
  if (threadIdx.x == 0) (void)xb_add(&bar[XB_XCNT(b.x)], 1u);
  return b;
}
DI void xcd_barrier_complete(unsigned* bar, unsigned x, unsigned& nloc, unsigned& nx) {
  const unsigned G = gridDim.x * gridDim.y * gridDim.z;
  unsigned sum, cnt, mine, sp = 0u;
  for (;;) {
    sum = 0u; cnt = 0u; mine = 0u;
#pragma unroll
    for (unsigned j = 0; j < 16; ++j) { const unsigned c = xb_ld(&bar[XB_XCNT(j)]); sum += c; cnt += (c > 0u) ? 1u : 0u; mine = (j == x) ? c : mine; }
    if (sum == G) break;
    __builtin_amdgcn_s_sleep(1);
    if ((++sp & 255u) == 0u) { if (xb_ld(&bar[XB_TMO])) break; if (sp > XB_SPIN_CAP) { atomicAdd(&bar[XB_TMO], 1u); break; } }
  }
  nloc = mine > 0u ? mine : 1u; nx = cnt > 0u ? cnt : 1u;
}
DI void xcd_barrier(const XcdBarrier& b) {
  asm volatile("s_waitcnt vmcnt(0)" ::: "memory");
  __syncthreads();
  if (threadIdx.x == 0) {
    unsigned* bar = b.bar;
    __builtin_amdgcn_s_waitcnt(0);
    unsigned nloc = b.st[0], nx = b.st[1];
    if (nloc == 0u) { xcd_barrier_complete(bar, b.x, nloc, nx); b.st[0] = nloc; b.st[1] = nx; }
    const unsigned old = xb_add(&bar[XB_XSUB(b.x)], 1u);
    const unsigned gen = old / nloc;
    if (old + 1u == (gen + 1u) * nloc) {
      __builtin_amdgcn_fence(__ATOMIC_RELEASE, "agent");
      asm volatile("s_waitcnt vmcnt(0)" ::: "memory");
      const unsigned og = xb_add(&bar[XB_TOP], 1u);
      const unsigned tg = og / nx;
      if (og + 1u == (tg + 1u) * nx) xb_add(&bar[XB_TOPGEN], 1u);
      else XB_SPIN(xb_ld(&bar[XB_TOPGEN]) == tg, bar);
      __builtin_amdgcn_fence(__ATOMIC_ACQUIRE, "agent");
      xb_add(&bar[XB_XGEN(b.x)], 1u);
      asm volatile("s_waitcnt vmcnt(0)" ::: "memory");
    } else {
      XB_SPIN(xb_ld(&bar[XB_XGEN(b.x)]) == gen, bar);
      __builtin_amdgcn_fence(__ATOMIC_ACQUIRE, "agent");
      asm volatile("s_waitcnt vmcnt(0)" ::: "memory");
    }
  }
  __syncthreads();
}

__global__ void __launch_bounds__(256, 2) mega(Params p, int ph_lo, int ph_hi) {
  __shared__ __attribute__((aligned(16))) unsigned char smem[SMEM_BYTES];
  __shared__ uint4 xb_words;
  cg::grid_group grid = cg::this_grid();
  if (threadIdx.x == 0) xb_words = make_uint4(0u, 0u, 0u, 0u);
  __syncthreads();
  XcdBarrier xb = xcd_barrier_post((unsigned*)(p.ws + OFF_BAR), (volatile LAS unsigned*)&xb_words);
  for (int ph = ph_lo; ph < ph_hi; ++ph) {
    if (ph == 8) continue;
    if (ph == 0) phase0(p, smem);
    else {
      const int l = (ph - 1) / 7, s = (ph - 1) % 7;
      if (s == 0) phase_norm(p, l, 0);
      else if (s == 1) phase_proj(p, l, smem);
      else if (s == 2) phase_mix(p, l, smem);
      else if (s == 3) phase_outproj(p, l, smem);
      else if (s == 4) phase_norm(p, l, 1);
      else if (s == 5) phase_peerq(p, l, smem);
      else phase_peer(p, l, smem);
      if (DUP_PHASE == s) {
        xcd_barrier(xb);
        if (s == 0) phase_norm(p, l, 0);
        else if (s == 1) phase_proj(p, l, smem);
        else if (s == 2) phase_mix(p, l, smem, 1);
        else if (s == 3) phase_outproj(p, l, smem);
        else if (s == 4) phase_norm(p, l, 1);
        else if (s == 5) phase_peerq(p, l, smem);
        else phase_peer(p, l, smem);
      }
    }
    if (ph + 1 < ph_hi) { if (ph_hi < 0) grid.sync(); xcd_barrier(xb); for (int q = 0; q < EXTRA_SYNCS; ++q) xcd_barrier(xb); }
  }
}

extern "C" void kernel_launch(void* const* d_in, const int* in_sizes, int n_in, void* d_out, int out_size, void* d_ws, size_t ws_size,
                              hipStream_t stream) {
  static int grid_blocks = 0;
  if (!grid_blocks) {
    int dev = 0, cus = 0, per_cu = 0;
    hipGetDevice(&dev);
    hipDeviceGetAttribute(&cus, hipDeviceAttributeMultiprocessorCount, dev);
    hipOccupancyMaxActiveBlocksPerMultiprocessor(&per_cu, mega, 256, 0);
    if (per_cu < 1) per_cu = 1;
    if (per_cu > 2) per_cu = 2;
    grid_blocks = cus * per_cu;
    if (grid_blocks > 1024) grid_blocks = 1024;
    if (ws_size < WS_END) fprintf(stderr, "kernel_launch: workspace too small (%zu < %zu)\n", ws_size, (size_t)WS_END);
  }
  Params p{};
  for (int i = 0; i < 31; ++i) p.in[i] = (const float*)d_in[i];
  p.out = (float*)d_out;
  p.ws = (unsigned char*)d_ws;
  (void)hipMemsetAsync((unsigned char*)d_ws + OFF_BAR, 0, XCD_BAR_WORDS * 4, stream);
#if COOP
  int lo = 0, hi = PH_END;
  void* args[] = {&p, &lo, &hi};
  hipError_t e = hipLaunchCooperativeKernel((void*)mega, dim3(grid_blocks), dim3(256), args, 0, stream);
  if (e != hipSuccess) fprintf(stderr, "cooperative launch failed: %s (grid %d)\n", hipGetErrorString(e), grid_blocks);
#else
  for (int ph = 0; ph < PH_END; ++ph) hipLaunchKernelGGL(mega, dim3(grid_blocks), dim3(256), 0, stream, p, ph, ph + 1);
#endif
}
```

```cpp
#include <hip/hip_runtime.h>
#include <hip/hip_cooperative_groups.h>
#include <cstdio>
namespace cg = cooperative_groups;

#define DI __device__ __forceinline__
typedef unsigned short u16;
typedef unsigned int u32;
using bf16x8 = __attribute__((ext_vector_type(8))) short;
using f32x16 = __attribute__((ext_vector_type(16))) float;
using u32x4 = __attribute__((ext_vector_type(4))) unsigned;
using u32x2 = __attribute__((ext_vector_type(2))) unsigned;
#define MFMA32(a, b, c) __builtin_amdgcn_mfma_f32_32x32x16_bf16((a), (b), (c), 0, 0, 0)

#ifndef PROBE_EPI4
#define PROBE_EPI4 1
#endif
#ifndef PROBE_EPI2
#define PROBE_EPI2 1
#endif
#ifndef EXTRA_SYNCS
#define EXTRA_SYNCS 0
#endif
#ifndef DUP_PHASE
#define DUP_PHASE -1
#endif
#ifndef MIXMASK
#define MIXMASK 63
#endif
#ifndef PH_END
#define PH_END 15
#endif
#ifndef COOP
#define COOP 1
#endif

constexpr int T = 16384, TP = 8192;
constexpr float EPS = 1e-6f;
constexpr int NPHASE = 15;
constexpr int SMEM_BYTES = 74240;

constexpr size_t OFF_WTIN = 0;
constexpr size_t OFF_WTOUT = OFF_WTIN + 10485760;
constexpr size_t OFF_WTQ = OFF_WTOUT + 4194304;
constexpr size_t OFF_SUBK = OFF_WTQ + 8388608;
constexpr size_t OFF_GWS = OFF_SUBK + 131072;
constexpr size_t OFF_PU = OFF_GWS + 262144;
constexpr size_t OFF_PV = OFF_PU + 67108864;
constexpr size_t OFF_MOD = OFF_PV + 67108864;
constexpr size_t OFF_ROPE = OFF_MOD + 147456;
constexpr size_t OFF_CKNA = OFF_ROPE + 4096;
constexpr size_t OFF_CVNA = OFF_CKNA + 524288;
constexpr size_t OFF_CKD = OFF_CVNA + 524288;
constexpr size_t OFF_CVD = OFF_CKD + 524288;
constexpr size_t OFF_CTR = OFF_CVD + 524288;
constexpr size_t OFF_H = OFF_CTR + 256;
constexpr size_t OFF_CONVA = OFF_H + 33554432;
constexpr size_t OFF_CONVG = OFF_CONVA + 8388608;
constexpr size_t OFF_QNA = OFF_CONVG + 8388608;
constexpr size_t OFF_KNA = OFF_QNA + 8388608;
constexpr size_t OFF_VNAT = OFF_KNA + 8388608;
constexpr size_t OFF_QD = OFF_VNAT + 8388608;
constexpr size_t OFF_KD = OFF_QD + 8388608;
constexpr size_t OFF_VDT = OFF_KD + 8388608;
constexpr size_t OFF_GU = OFF_VDT + 8388608;
constexpr size_t OFF_GV = OFF_GU + 8388608;
constexpr size_t OFF_MIX = OFF_GV + 8388608;
constexpr size_t OFF_XMID = OFF_MIX + 33554432;
constexpr size_t OFF_EIDX = OFF_XMID + 67108864;
constexpr size_t OFF_GATE = OFF_EIDX + 8388608;
constexpr size_t OFF_LTMP = OFF_GATE + 8388608;
constexpr size_t OFF_SU = OFF_LTMP + 16777216;
constexpr size_t OFF_SV = OFF_SU + 131072;
constexpr size_t OFF_BAR = OFF_SV + 131072;
constexpr size_t OFF_WQB = OFF_BAR + 16384;
constexpr size_t WS_END = OFF_WQB + 8388608;

constexpr size_t OUT_NAKV = 16777216;
constexpr size_t OUT_DKV = 25165824;

struct Params {
  const float* in[31];
  float* out;
  unsigned char* ws;
};

DI int tid_opaque() { int t = threadIdx.x; asm volatile("" : "+v"(t)); return t; }
typedef __bf16 bf16x2_t __attribute__((ext_vector_type(2)));
typedef float f32x2_t __attribute__((ext_vector_type(2)));
DI u32 f2bf(float x) { u32 u = __float_as_uint(x); u += 0x7fffu + ((u >> 16) & 1u); return u >> 16; }
DI u32 pack2(float a, float b) { f32x2_t v = {a, b}; return __builtin_bit_cast(u32, __builtin_convertvector(v, bf16x2_t)); }
DI float bf_lo(u32 p) { return __uint_as_float(p << 16); }
DI float bf_hi(u32 p) { return __uint_as_float(p & 0xffff0000u); }
DI float bf1(u16 v) { return __uint_as_float(((u32)v) << 16); }
DI float sigmoid_f(float x) { return __builtin_amdgcn_rcpf(1.f + __expf(-x)); }
DI float gelu_f(float x) {
  float u = 0.7978845608028654f * (x + 0.044715f * x * x * x);
  float e = __expf(2.f * u);
  float t = 1.f - 2.f * __builtin_amdgcn_rcpf(e + 1.f);
  return 0.5f * x * (1.f + t);
}
DI int crow(int i, int h) { return (i & 3) + 8 * (i >> 2) + 4 * h; }
DI int clampi(int v, int lo, int hi) { return v < lo ? lo : (v > hi ? hi : v); }
DI void st8(u16* dst, const float* v) {
  u32x4 o; o[0] = pack2(v[0], v[1]); o[1] = pack2(v[2], v[3]); o[2] = pack2(v[4], v[5]); o[3] = pack2(v[6], v[7]);
  *(u32x4*)dst = o;
}
DI float swz_xor(float v, int d) {
  int r;
  if (d == 1) r = __builtin_amdgcn_ds_swizzle(__float_as_int(v), (1 << 10) | 0x1F);
  else if (d == 2) r = __builtin_amdgcn_ds_swizzle(__float_as_int(v), (2 << 10) | 0x1F);
  else if (d == 4) r = __builtin_amdgcn_ds_swizzle(__float_as_int(v), (4 << 10) | 0x1F);
  else if (d == 8) r = __builtin_amdgcn_ds_swizzle(__float_as_int(v), (8 << 10) | 0x1F);
  else r = __builtin_amdgcn_ds_swizzle(__float_as_int(v), (16 << 10) | 0x1F);
  return __int_as_float(r);
}
DI float wave_sum(float v) {
#pragma unroll
  for (int d = 32; d >= 1; d >>= 1) v += __shfl_xor(v, d);
  return v;
}
DI const float* xin_row(const Params& p, int l, int t) {
  if (l == 0) return t < TP ? p.in[0] + (size_t)t * 1024 : p.in[1] + (size_t)(t - TP) * 1024;
  return p.out + (size_t)t * 1024;
}
DI int mod_row(int t) { return t < TP ? 0 : 1 + ((t - TP) >> 12); }
template <typename Tp> DI Tp* wsp(const Params& p, size_t off) { return (Tp*)(p.ws + off); }

DI void transpose_tile(const float* src, u16* dst, int K, int N, int k0, int n0, float* t) {
  const int tid = tid_opaque();
#pragma unroll
  for (int i = 0; i < 16; ++i) {
    int k = i * 4 + (tid >> 6), n = tid & 63;
    t[k * 65 + n] = src[(size_t)(k0 + k) * N + n0 + n];
  }
  __syncthreads();
  {
    int n = tid >> 2, kq = (tid & 3) * 16;
    float v[16];
#pragma unroll
    for (int j = 0; j < 16; ++j) v[j] = t[(kq + j) * 65 + n];
    u16* d = dst + (size_t)(n0 + n) * K + k0 + kq;
    st8(d, v); st8(d + 8, v + 8);
  }
  __syncthreads();
}

DI void convert_range(const float* src, u16* dst, size_t n8) {
  size_t stride = (size_t)gridDim.x * 256;
  const int tid_ = tid_opaque();
  for (size_t i = (size_t)blockIdx.x * 256 + tid_; i < n8; i += stride) {
    float4 a = ((const float4*)src)[2 * i], b = ((const float4*)src)[2 * i + 1];
    u32x4 o; o[0] = pack2(a.x, a.y); o[1] = pack2(a.z, a.w); o[2] = pack2(b.x, b.y); o[3] = pack2(b.z, b.w);
    ((u32x4*)dst)[i] = o;
  }
}

DI void quant_rows64(const float* src, unsigned char* dst, float* rscale, int row0, const bool as_int4) {
  const int tid_ = tid_opaque();
  const int lane = tid_ & 63;
  const int nrows = row0 + 64, nw = 1;
#pragma nounroll
  for (int rb = row0 + (tid_ >> 6) * 16; rb < row0 + (tid_ >> 6) * 16 + 16; rb += 2) {
    float4 v[2][4];
    float am[2];
#pragma unroll
    for (int u = 0; u < 2; ++u) {
      const int row = rb + u * nw;
      const float* s = src + (size_t)(row < nrows ? row : rb) * 1024 + lane * 16;
      float a = 0.f;
#pragma unroll
      for (int i = 0; i < 4; ++i) {
        v[u][i] = *(const float4*)(s + i * 4);
        a = fmaxf(a, fmaxf(fmaxf(fabsf(v[u][i].x), fabsf(v[u][i].y)), fmaxf(fabsf(v[u][i].z), fabsf(v[u][i].w))));
      }
      am[u] = a;
    }
#pragma unroll
    for (int u = 0; u < 2; ++u) {
#pragma unroll
      for (int d = 32; d >= 1; d >>= 1) am[u] = fmaxf(am[u], __shfl_xor(am[u], d));
    }
#pragma unroll
    for (int u = 0; u < 2; ++u) {
      const int row = rb + u * nw;
      if (row < nrows) {
        const float sc = am[u] > 0.f ? (as_int4 ? 7.f : 6.f) / am[u] : 0.f;
        u32x2 o;
        if (as_int4) {
#pragma unroll
          for (int hh = 0; hh < 2; ++hh) {
            const float f[8] = {v[u][2 * hh].x, v[u][2 * hh].y, v[u][2 * hh].z, v[u][2 * hh].w, v[u][2 * hh + 1].x, v[u][2 * hh + 1].y, v[u][2 * hh + 1].z, v[u][2 * hh + 1].w};
            u32 pk = 0u;
#pragma unroll
            for (int i = 0; i < 8; ++i) { int q = (int)__builtin_rintf(f[i] * sc); q = q < -7 ? -7 : (q > 7 ? 7 : q); pk |= ((u32)q & 0xFu) << (4 * i); }
            o[hh] = pk;
          }
        } else
#pragma unroll
        for (int hh = 0; hh < 2; ++hh) {
          u32 pk = 0u;
          pk = __builtin_amdgcn_cvt_scalef32_pk_fp4_f32(pk, v[u][2 * hh].x * sc, v[u][2 * hh].y * sc, 1.0f, 0);
          pk = __builtin_amdgcn_cvt_scalef32_pk_fp4_f32(pk, v[u][2 * hh].z * sc, v[u][2 * hh].w * sc, 1.0f, 1);
          pk = __builtin_amdgcn_cvt_scalef32_pk_fp4_f32(pk, v[u][2 * hh + 1].x * sc, v[u][2 * hh + 1].y * sc, 1.0f, 2);
          pk = __builtin_amdgcn_cvt_scalef32_pk_fp4_f32(pk, v[u][2 * hh + 1].z * sc, v[u][2 * hh + 1].w * sc, 1.0f, 3);
          o[hh] = pk;
        }
        *(u32x2*)(dst + (size_t)row * 512 + lane * 8) = o;
        if (lane == 0) rscale[row] = am[u] * (as_int4 ? (1.f / 7.f) : (1.f / 6.f));
      }
    }
  }
}

DI void transpose_item(const Params& p, int item, float* sf) {
  const float* src; u16* dst; int N, it;
  if (item < 1280) { it = item; N = 2560; src = p.in[10]; dst = wsp<u16>(p, OFF_WTIN); }
  else if (item < 1792) { it = item - 1280; N = 1024; src = p.in[26]; dst = wsp<u16>(p, OFF_WTOUT); }
  else { it = item - 1792; N = 2048; src = p.in[27]; dst = wsp<u16>(p, OFF_WTQ); }
  int per_layer = 16 * (N / 64);
  int l = it / per_layer, r = it % per_layer;
  int kt = r / (N / 64), nt = r % (N / 64);
  transpose_tile(src + (size_t)l * 1024 * N, dst + (size_t)l * 1024 * N, 1024, N, kt * 64, nt * 64, sf);
}

DI void phase0(const Params& p, unsigned char* smem) {
  const int tid = tid_opaque(), bid = blockIdx.x, nb = gridDim.x;
  float* sf = (float*)smem;
  if (bid == 0 && tid < 8) wsp<int>(p, OFF_CTR)[tid] = 0;
  for (int i = tid; i < 3072; i += 256) {
    int r = i >> 10, k = i & 1023;
    float c = (r == 0) ? p.in[5][k] : p.in[4][(r - 1) * 1024 + k];
    sf[i] = c * sigmoid_f(c);
  }
  __syncthreads();
  for (int item = bid; item < 384; item += nb) {
    const int l = item / 192, n0 = (item % 192) * 32, col = tid & 31, kg = tid >> 5;
    float a0 = 0.f, a1 = 0.f, a2 = 0.f;
    const float* wm = p.in[6] + (size_t)l * 1024 * 6144 + n0 + col;
    for (int k0 = kg * 128; k0 < kg * 128 + 128; k0 += 16) {
      float w[16];
#pragma unroll
      for (int j = 0; j < 16; ++j) w[j] = wm[(size_t)(k0 + j) * 6144];
#pragma unroll
      for (int j = 0; j < 16; ++j) { a0 += sf[k0 + j] * w[j]; a1 += sf[1024 + k0 + j] * w[j]; a2 += sf[2048 + k0 + j] * w[j]; }
    }
    float* red = sf + 3072;
    red[(kg * 3 + 0) * 32 + col] = a0; red[(kg * 3 + 1) * 32 + col] = a1; red[(kg * 3 + 2) * 32 + col] = a2;
    __syncthreads();
    if (tid < 96) {
      int r = tid >> 5, c = tid & 31;
      float s = 0.f;
#pragma unroll
      for (int g = 0; g < 8; ++g) s += red[(g * 3 + r) * 32 + c];
      wsp<float>(p, OFF_MOD)[(size_t)(l * 3 + r) * 6144 + n0 + c] = s + p.in[7][l * 6144 + n0 + c];
    }
    __syncthreads();
  }
  __syncthreads();
  for (int item = bid; item < 640; item += nb) transpose_item(p, item, sf);
  convert_range(p.in[27], wsp<u16>(p, OFF_WQB), (size_t)2 * 1024 * 2048 / 8);
  convert_range(p.in[28], wsp<u16>(p, OFF_SUBK), (size_t)2 * 2 * 128 * 128 / 8);
  convert_range(p.in[24], wsp<u16>(p, OFF_GWS), (size_t)2 * 4 * 128 * 128 / 8);
  {
    size_t stride = (size_t)nb * 256;
    for (size_t i = (size_t)bid * 256 + tid; i < 262144; i += stride) {
      int d = i & 63, m = (i >> 6) & 255, bl_h = (int)(i >> 14);
      int blv = bl_h >> 2, hh = bl_h & 3;
      size_t sk = ((((size_t)blv * 2 + 0) * 4 + hh) * 256 + m) * 64 + d;
      size_t sv = ((((size_t)blv * 2 + 1) * 4 + hh) * 256 + m) * 64 + d;
      size_t dv = ((size_t)bl_h * 64 + d) * 256 + m;
      wsp<u16>(p, OFF_CKNA)[i] = (u16)f2bf(p.in[2][sk]);
      wsp<u16>(p, OFF_CVNA)[dv] = (u16)f2bf(p.in[2][sv]);
      wsp<u16>(p, OFF_CKD)[i] = (u16)f2bf(p.in[3][sk]);
      wsp<u16>(p, OFF_CVD)[dv] = (u16)f2bf(p.in[3][sv]);
    }
  }
  if (bid == (nb > 1 ? 1 : 0)) {
    for (int i = tid; i < 512; i += 256) {
      int pos = i >> 3, k = i & 7;
      const float invs[8] = {1.0f, 0.31622776601683794f, 0.1f, 0.031622776601683794f, 0.01f, 0.0031622776601683794f, 0.001f, 0.00031622776601683794f};
      float inv = invs[0];
#pragma unroll
      for (int q = 1; q < 8; ++q) inv = (k == q) ? invs[q] : inv;
      float ang = (float)pos * inv;
      float rev = ang * 0.15915494309189535f;
      rev = rev - floorf(rev);
      wsp<float>(p, OFF_ROPE)[i * 2 + 0] = __builtin_amdgcn_cosf(rev);
      wsp<float>(p, OFF_ROPE)[i * 2 + 1] = __builtin_amdgcn_sinf(rev);
    }
  }
}

DI void phase_norm(const Params& p, int l, int which) {
  const int tid = tid_opaque(), lane = tid & 63;
  const int gw = blockIdx.x * 4 + (tid >> 6), nw = gridDim.x * 4;
  const float* gam = p.in[which == 0 ? 8 : 9] + l * 1024;
  u16* H = wsp<u16>(p, OFF_H);
  for (int tb = gw; tb < T; tb += nw * 4) {
    float4 v[4][4];
    float ss[4];
#pragma unroll
    for (int u = 0; u < 4; ++u) {
      const int t = tb + u * nw;
      if (t < T) {
        const float* xr = (which == 0) ? xin_row(p, l, t) : wsp<float>(p, OFF_XMID) + (size_t)t * 1024;
#pragma unroll
        for (int i = 0; i < 4; ++i) v[u][i] = *(const float4*)(xr + i * 256 + lane * 4);
      } else {
#pragma unroll
        for (int i = 0; i < 4; ++i) v[u][i] = make_float4(0.f, 0.f, 0.f, 0.f);
      }
    }
#pragma unroll
    for (int u = 0; u < 4; ++u) {
      float s = 0.f;
#pragma unroll
      for (int i = 0; i < 4; ++i) s += v[u][i].x * v[u][i].x + v[u][i].y * v[u][i].y + v[u][i].z * v[u][i].z + v[u][i].w * v[u][i].w;
      ss[u] = wave_sum(s);
    }
#pragma unroll
    for (int u = 0; u < 4; ++u) {
      const int t = tb + u * nw;
      if (t < T) {
        const float* md = wsp<float>(p, OFF_MOD) + (size_t)(l * 3 + mod_row(t)) * 6144 + (which == 0 ? 0 : 3072);
        const float rs = rsqrtf(ss[u] * (1.f / 1024.f) + EPS);
#pragma unroll
        for (int i = 0; i < 4; ++i) {
          int n = i * 256 + lane * 4;
          float4 g = *(const float4*)(gam + n), sh = *(const float4*)(md + n), sc = *(const float4*)(md + 1024 + n);
          float o0 = v[u][i].x * rs * g.x * (1.f + sc.x) + sh.x;
          float o1 = v[u][i].y * rs * g.y * (1.f + sc.y) + sh.y;
          float o2 = v[u][i].z * rs * g.z * (1.f + sc.z) + sh.z;
          float o3 = v[u][i].w * rs * g.w * (1.f + sc.w) + sh.w;
          u32x2 o; o[0] = pack2(o0, o1); o[1] = pack2(o2, o3);
          *(u32x2*)(H + (size_t)t * 1024 + n) = o;
        }
      }
    }
  }
}

struct GemmPre { u32x4 ra[4], rb[4]; };
DI void gemm_prefetch(const int tid, const u16* A, const u16* Bt, int K, int m0, int n0, GemmPre& pre) {
  const int lrow = tid >> 3, lkc = (tid & 7) * 8;
  const u16* ag = A + (size_t)(m0 + lrow) * K + lkc;
  const u16* bg = Bt + (size_t)(n0 + lrow) * K + lkc;
#pragma unroll
  for (int i = 0; i < 4; ++i) { pre.ra[i] = *(const u32x4*)(ag + (size_t)i * 32 * K); pre.rb[i] = *(const u32x4*)(bg + (size_t)i * 32 * K); }
}
template <bool PRE = false>
DI void gemm_main(const int tid, const u16* A, const u16* Bt, int K, int m0, int n0, u16* sm, f32x16 (&acc)[2][2], int lda = 0, int ldb = 0, const GemmPre* pre = nullptr) {
  if (lda == 0) lda = K;
  if (ldb == 0) ldb = K;
  const int lane = tid & 63, w = tid >> 6, r = lane & 31, h = lane >> 5;
  const int wm = w >> 1, wn = w & 1;
  const int lrow = tid >> 3, lkc = (tid & 7) * 8;
  const u16* ag = A + (size_t)(m0 + lrow) * lda + lkc;
  const u16* bg = Bt + (size_t)(n0 + lrow) * ldb + lkc;
  u32x4 ra[4], rb[4];
#pragma unroll
  for (int a = 0; a < 2; ++a)
#pragma unroll
    for (int b = 0; b < 2; ++b)
#pragma unroll
      for (int i = 0; i < 16; ++i) acc[a][b][i] = 0.f;
  __syncthreads();
  if (PRE) {
#pragma unroll
    for (int i = 0; i < 4; ++i) { ra[i] = pre->ra[i]; rb[i] = pre->rb[i]; }
  } else {
#pragma unroll
    for (int i = 0; i < 4; ++i) { ra[i] = *(const u32x4*)(ag + (size_t)i * 32 * lda); rb[i] = *(const u32x4*)(bg + (size_t)i * 32 * ldb); }
  }
#pragma unroll
  for (int i = 0; i < 4; ++i) {
    *(u32x4*)(sm + (lrow + 32 * i) * 72 + lkc) = ra[i];
    *(u32x4*)(sm + 9216 + (lrow + 32 * i) * 72 + lkc) = rb[i];
  }
  __syncthreads();
  const int nk = K >> 6;
#pragma nounroll
  for (int kt = 0; kt < nk; ++kt) {
    const bool more = (kt + 1 < nk);
    if (more) {
#pragma unroll
      for (int i = 0; i < 4; ++i) {
        ra[i] = *(const u32x4*)(ag + (size_t)i * 32 * lda + (kt + 1) * 64);
        rb[i] = *(const u32x4*)(bg + (size_t)i * 32 * ldb + (kt + 1) * 64);
      }
    }
    const u16* sa = sm + (kt & 1) * 18432;
    const u16* sb = sa + 9216;
    {
      bf16x8 af[4][2], bfr[4][2];
#pragma unroll
      for (int ks = 0; ks < 4; ++ks) {
#pragma unroll
        for (int mt = 0; mt < 2; ++mt) af[ks][mt] = *(const bf16x8*)(sa + (wm * 64 + mt * 32 + r) * 72 + ks * 16 + 8 * h);
#pragma unroll
        for (int nt = 0; nt < 2; ++nt) bfr[ks][nt] = *(const bf16x8*)(sb + (wn * 64 + nt * 32 + r) * 72 + ks * 16 + 8 * h);
      }
      __builtin_amdgcn_sched_barrier(0);
#pragma unroll
      for (int ks = 0; ks < 4; ++ks)
#pragma unroll
        for (int mt = 0; mt < 2; ++mt)
#pragma unroll
          for (int nt = 0; nt < 2; ++nt) acc[mt][nt] = MFMA32(af[ks][mt], bfr[ks][nt], acc[mt][nt]);
      __builtin_amdgcn_sched_barrier(0);
    }
    if (more) {
      u16* da = sm + ((kt + 1) & 1) * 18432;
#pragma unroll
      for (int i = 0; i < 4; ++i) {
        *(u32x4*)(da + (lrow + 32 * i) * 72 + lkc) = ra[i];
        *(u32x4*)(da + 9216 + (lrow + 32 * i) * 72 + lkc) = rb[i];
      }
    }
    __syncthreads();
  }
}

template <int STRIDE = 129>
DI void acc_to_lds(const int tid, const f32x16 (&acc)[2][2], float* Ct) {
  const int lane = tid & 63, w = tid >> 6, r = lane & 31, h = lane >> 5;
  const int wm = w >> 1, wn = w & 1;
#pragma unroll
  for (int mt = 0; mt < 2; ++mt)
#pragma unroll
    for (int nt = 0; nt < 2; ++nt)
#pragma unroll
      for (int i = 0; i < 16; ++i) Ct[(wm * 64 + mt * 32 + crow(i, h)) * STRIDE + wn * 64 + nt * 32 + r] = acc[mt][nt][i];
}

DI void fusedwq_item(const Params& p, int item, unsigned char* smem) {
  const int tid = tid_opaque();
  const int l = item >> 7, hp = (item >> 3) & 15, dc = item & 7;
  const u16* A = wsp<u16>(p, OFF_SUBK) + (size_t)(l * 2 + (hp & 1)) * 128 * 128;
  const u16* Bt = wsp<u16>(p, OFF_WQB) + (size_t)l * 1024 * 2048 + hp * 128;
  f32x16 acc[2][2];
  gemm_main(tid, A, Bt, 128, 0, dc * 128, (u16*)smem, acc, 128, 2048);
  acc_to_lds<132>(tid, acc, (float*)smem);
  __syncthreads();
  const float* Ct = (const float*)smem;
  u16* dst = wsp<u16>(p, OFF_WTQ) + (size_t)l * 2048 * 1024 + (size_t)(hp * 128) * 1024 + dc * 128;
  const int c = (tid & 31) * 4;
#pragma unroll
  for (int it = 0; it < 16; ++it) {
    const int row = it * 8 + (tid >> 5);
    const float4 cv = *(const float4*)(Ct + row * 132 + c);
    u32x2 o; o[0] = pack2(cv.x, cv.y); o[1] = pack2(cv.z, cv.w);
    *(u32x2*)(dst + (size_t)row * 1024 + c) = o;
  }
  __syncthreads();
}

DI void epi_proj(const int tid, const Params& p, int l, int m0, int ntile, const float* Ct) {
  const int row = tid >> 1, ch = tid & 1;
  const int t = m0 + row;
  const int seg = ntile >> 1, half = ntile & 1;
  const float* cr = Ct + row * 129 + ch * 64;
  const int path = (t >= TP) ? 1 : 0;
  int b, pos, L;
  if (!path) { b = t >> 8; pos = t & 255; L = 256; } else { b = (t - TP) >> 12; pos = (t - TP) & 4095; L = 4096; }
  const int head = half * 2 + ch;
  const int cs = half * 128 + ch * 64;
  const size_t pbase = (size_t)path * 2097152;
  const size_t hm = pbase + ((size_t)(b * 4 + head) * L + pos) * 64;
  const size_t vt = pbase + ((size_t)(b * 4 + head) * 64) * L + pos;
  if (seg == 0 || seg == 1) {
    u16* dst = wsp<u16>(p, seg == 0 ? OFF_CONVA : OFF_CONVG) + (size_t)t * 256 + cs;
#pragma unroll
    for (int c8 = 0; c8 < 8; ++c8) { float v[8];
#pragma unroll
      for (int j = 0; j < 8; ++j) v[j] = cr[c8 * 8 + j];
      st8(dst + c8 * 8, v); }
  } else if (seg == 8 || seg == 9) {
    u16* dst = wsp<u16>(p, seg == 8 ? OFF_GU : OFF_GV) + (size_t)t * 256 + cs;
#pragma unroll
    for (int c8 = 0; c8 < 8; ++c8) { float v[8];
#pragma unroll
      for (int j = 0; j < 8; ++j) v[j] = gelu_f(cr[c8 * 8 + j]);
      st8(dst + c8 * 8, v); }
  } else if (seg == 2 || seg == 3) {
    float ss = 0.f;
#pragma unroll
    for (int j = 0; j < 64; ++j) ss += cr[j] * cr[j];
    const float rs = rsqrtf(ss * (1.f / 64.f) + EPS);
    const float* g = p.in[seg == 2 ? 15 : 16] + l * 64;
    u16* dst = wsp<u16>(p, seg == 2 ? OFF_QNA : OFF_KNA) + hm;
    float* okv = p.out + OUT_NAKV + (((((size_t)b * 2 + l) * 2 + 0) * 4 + head) * 256 + pos) * 64;
    const bool wkv = (seg == 3) && !path;
#pragma unroll
    for (int c8 = 0; c8 < 8; ++c8) { float v[8];
#pragma unroll
      for (int j = 0; j < 8; ++j) v[j] = cr[c8 * 8 + j] * rs * g[c8 * 8 + j];
      st8(dst + c8 * 8, v);
      if (wkv) { *(float4*)(okv + c8 * 8) = make_float4(v[0], v[1], v[2], v[3]); *(float4*)(okv + c8 * 8 + 4) = make_float4(v[4], v[5], v[6], v[7]); } }
  } else if (seg == 4 || seg == 7) {
    u16* dst = wsp<u16>(p, seg == 4 ? OFF_VNAT : OFF_VDT) + vt;
    float* okv = p.out + (seg == 4 ? OUT_NAKV : OUT_DKV) + (((((size_t)b * 2 + l) * 2 + 1) * 4 + head) * 256 + pos) * 64;
#pragma unroll
    for (int c8 = 0; c8 < 8; ++c8) { float v[8];
#pragma unroll
      for (int j = 0; j < 8; ++j) { v[j] = cr[c8 * 8 + j]; dst[(size_t)(c8 * 8 + j) * L] = (u16)f2bf(v[j]); }
      if (!path) { *(float4*)(okv + c8 * 8) = make_float4(v[0], v[1], v[2], v[3]); *(float4*)(okv + c8 * 8 + 4) = make_float4(v[4], v[5], v[6], v[7]); } }
  } else {
    const float* g = p.in[seg == 5 ? 18 : 19] + l * 32;
    u16* dst = wsp<u16>(p, seg == 5 ? OFF_QD : OFF_KD) + hm;
    float* okv = p.out + OUT_DKV + (((((size_t)b * 2 + l) * 2 + 0) * 4 + head) * 256 + pos) * 64;
    const bool wkv = (seg == 6) && !path;
    const float* rope = wsp<float>(p, OFF_ROPE);
    const int grow = pos >> 6, gcol = pos & 63;
#pragma unroll
    for (int sub = 0; sub < 2; ++sub) {
      float ss = 0.f;
#pragma unroll
      for (int j = 0; j < 32; ++j) ss += cr[sub * 32 + j] * cr[sub * 32 + j];
      const float rs = rsqrtf(ss * (1.f / 32.f) + EPS);
#pragma unroll
      for (int ps = 0; ps < 2; ++ps) {
        float x1[8], x2[8];
#pragma unroll
        for (int i = 0; i < 8; ++i) {
          x1[i] = cr[sub * 32 + ps * 16 + i] * rs * g[ps * 16 + i];
          x2[i] = cr[sub * 32 + ps * 16 + 8 + i] * rs * g[ps * 16 + 8 + i];
        }
        if (wkv) {
          float* o = okv + sub * 32 + ps * 16;
          *(float4*)(o) = make_float4(x1[0], x1[1], x1[2], x1[3]); *(float4*)(o + 4) = make_float4(x1[4], x1[5], x1[6], x1[7]);
          *(float4*)(o + 8) = make_float4(x2[0], x2[1], x2[2], x2[3]); *(float4*)(o + 12) = make_float4(x2[4], x2[5], x2[6], x2[7]);
        }
        if (path) {
          const float* rp = rope + (size_t)((ps == 0 ? grow : gcol) * 8) * 2;
#pragma unroll
          for (int i = 0; i < 8; ++i) {
            float c = rp[i * 2], s = rp[i * 2 + 1];
            float a1 = x1[i] * c - x2[i] * s, a2 = x1[i] * s + x2[i] * c;
            x1[i] = a1; x2[i] = a2;
          }
        }
        st8(dst + sub * 32 + ps * 16, x1);
        st8(dst + sub * 32 + ps * 16 + 8, x2);
      }
    }
  }
}

DI void phase_proj(const Params& p, int l, unsigned char* smem) {
  const int tid = tid_opaque();
  const u16* A = wsp<u16>(p, OFF_H);
  const u16* Bt = wsp<u16>(p, OFF_WTIN) + (size_t)l * 2560 * 1024;
  GemmPre pre;
  gemm_prefetch(tid, A, Bt, 1024, ((int)blockIdx.x / 20) * 128, ((int)blockIdx.x % 20) * 128, pre);
  for (int tile = blockIdx.x; tile < 128 * 20; tile += gridDim.x) {
    int mt = tile / 20, nt = tile % 20;
    f32x16 acc[2][2];
    gemm_main<true>(tid, A, Bt, 1024, mt * 128, nt * 128, (u16*)smem, acc, 0, 0, &pre);
    { const int nx = tile + gridDim.x; if (nx < 128 * 20) gemm_prefetch(tid, A, Bt, 1024, (nx / 20) * 128, (nx % 20) * 128, pre); }
    acc_to_lds(tid, acc, (float*)smem);
    __syncthreads();
    epi_proj(tid, p, l, mt * 128, nt, (const float*)smem);
#if PROBE_EPI2 > 1
    asm volatile("" ::: "memory");
    epi_proj(tid, p, l, mt * 128, nt, (const float*)smem);
#endif
  }
}

template <int MODE>
DI void attn_item(const Params& p, int l, int item, unsigned char* smem) {
  constexpr bool LAT = (MODE == 1 || MODE == 3);
  constexpr bool DIFF = (MODE >= 2);
  constexpr int NS = DIFF ? 2 : 1;
  const int tid = tid_opaque(), lane = tid & 63, w = tid >> 6, r = lane & 31, h = lane >> 5;
  u16* sKV = (u16*)smem;
  float* sBias = (float*)(smem + 36864);
  u16* sO = (u16*)(smem + 36864 + 2048) + w * 32 * 72;
  int bh, L, path, qpos0;
  if (LAT) { bh = item >> 5; qpos0 = (item & 31) * 128; L = 4096; path = 1; }
  else { bh = item >> 1; qpos0 = (item & 1) * 128; L = 256; path = 0; }
  const int b = bh >> 2, hd = bh & 3;
  const size_t pbase = (size_t)path * 2097152;
  const u16* Qb = wsp<u16>(p, DIFF ? OFF_QD : OFF_QNA) + pbase + ((size_t)bh * L) * 64;
  const u16* Kb = wsp<u16>(p, DIFF ? OFF_KD : OFF_KNA) + pbase + ((size_t)bh * L) * 64;
  const u16* Vb = wsp<u16>(p, DIFF ? OFF_VDT : OFF_VNAT) + pbase + (size_t)bh * 64 * L;
  const u16* CK = wsp<u16>(p, DIFF ? OFF_CKD : OFF_CKNA) + ((size_t)((b * 2 + l) * 4 + hd) * 256) * 64;
  const u16* CV = wsp<u16>(p, DIFF ? OFF_CVD : OFF_CVNA) + ((size_t)((b * 2 + l) * 4 + hd) * 64) * 256;
  const int qpos = qpos0 + w * 32 + r;
  bf16x8 qf[4];
#pragma unroll
  for (int ks = 0; ks < 4; ++ks) qf[ks] = *(const bf16x8*)(Qb + (size_t)qpos * 64 + ks * 16 + 8 * h);
  const int qr = qpos >> 6, qc = qpos & 63;
  const int r0q = clampi(qr - 4, 0, 56), c0q = clampi(qc - 8, 0, 48);
  int rlo = 0, nloc = L / 64;
  if (MODE == 1) { int ra = qpos0 >> 6; rlo = clampi(ra - 4, 0, 56); int rhi = clampi(ra + 1 - 4, 0, 56) + 7; nloc = rhi - rlo + 1; }
  const int nctx = LAT ? 4 : 0;
  const int ntiles = nctx + nloc;
  const float scale = DIFF ? 0.17677669529663687f : 0.125f;
  if (MODE == 1) { for (int i = tid; i < 465; i += 256) sBias[i] = p.in[17][(size_t)(l * 4 + hd) * 465 + i]; }

  u32x4 rk[2], rv[2];
  auto gl = [&](int ti) {
    const u16* ks_; const u16* vs_; int vstr;
    if (LAT && ti < 4) { ks_ = CK + (size_t)ti * 64 * 64; vs_ = CV + ti * 64; vstr = 256; }
    else { int j = ti - nctx; int kp = (MODE == 1) ? (rlo + j) * 64 : j * 64; ks_ = Kb + (size_t)kp * 64; vs_ = Vb + kp; vstr = L; }
#pragma unroll
    for (int i = 0; i < 2; ++i) {
      int c = tid + 256 * i;
      rk[i] = *(const u32x4*)(ks_ + c * 8);
      rv[i] = *(const u32x4*)(vs_ + (size_t)(c >> 3) * vstr + (c & 7) * 8);
    }
  };
  f32x16 o[NS][2];
  float m_[NS], l_[NS];
#pragma unroll
  for (int s = 0; s < NS; ++s) { m_[s] = -1e30f; l_[s] = 0.f;
#pragma unroll
    for (int dt = 0; dt < 2; ++dt)
#pragma unroll
      for (int i = 0; i < 16; ++i) o[s][dt][i] = 0.f; }

  gl(0);
  __syncthreads();
#pragma unroll
  for (int i = 0; i < 2; ++i) {
    int c = tid + 256 * i;
    *(u32x4*)(sKV + (c >> 3) * 72 + (c & 7) * 8) = rk[i];
    *(u32x4*)(sKV + 4608 + (c >> 3) * 72 + (c & 7) * 8) = rv[i];
  }
  if (ntiles > 1) gl(1);
  __syncthreads();
#pragma nounroll
  for (int ti = 0; ti < ntiles; ++ti) {
    const u16* sK = sKV + (ti & 1) * 9216;
    const u16* sV = sK + 4608;
    if (ti + 1 < ntiles) {
      u16* nK = sKV + ((ti + 1) & 1) * 9216;
#pragma unroll
      for (int i = 0; i < 2; ++i) {
        int c = tid + 256 * i;
        *(u32x4*)(nK + (c >> 3) * 72 + (c & 7) * 8) = rk[i];
        *(u32x4*)(nK + 4608 + (c >> 3) * 72 + (c & 7) * 8) = rv[i];
      }
    }
    if (ti + 2 < ntiles) gl(ti + 2);
    const bool local = (ti >= nctx);
    const int kr = rlo + (ti - nctx);
#pragma unroll
    for (int s = 0; s < NS; ++s) {
      f32x16 sc[2];
#pragma unroll
      for (int kt2 = 0; kt2 < 2; ++kt2) {
#pragma unroll
        for (int i = 0; i < 16; ++i) sc[kt2][i] = 0.f;
        if (!DIFF) {
#pragma unroll
          for (int ks = 0; ks < 4; ++ks) {
            bf16x8 a = *(const bf16x8*)(sK + (kt2 * 32 + r) * 72 + ks * 16 + 8 * h);
            sc[kt2] = MFMA32(a, qf[ks], sc[kt2]);
          }
        } else {
#pragma unroll
          for (int ks = 0; ks < 2; ++ks) {
            bf16x8 a = *(const bf16x8*)(sK + (kt2 * 32 + r) * 72 + (s * 2 + ks) * 16 + 8 * h);
            sc[kt2] = MFMA32(a, qf[s * 2 + ks], sc[kt2]);
          }
        }
      }
      constexpr float KSC = (DIFF ? 0.17677669529663687f : 0.125f) * 1.4426950408889634f;
      float mx = -INFINITY;
      if (MODE == 1) {
#pragma unroll
        for (int kt2 = 0; kt2 < 2; ++kt2)
#pragma unroll
          for (int i = 0; i < 16; ++i) {
            float v = sc[kt2][i] * KSC;
            if (local) {
              int kc = kt2 * 32 + crow(i, h);
              bool valid = (kr >= r0q) && (kr < r0q + 8) && (kc >= c0q) && (kc < c0q + 16);
              int bi = valid ? ((kr - qr + 7) * 31 + (kc - qc + 15)) : 0;
              float bv = sBias[bi];
              v = valid ? v + bv * 1.4426950408889634f : -INFINITY;
            }
            sc[kt2][i] = v;
            mx = fmaxf(mx, v);
          }
      } else {
#pragma unroll
        for (int kt2 = 0; kt2 < 2; ++kt2)
#pragma unroll
          for (int i = 0; i < 16; ++i) mx = fmaxf(mx, sc[kt2][i]);
        mx *= KSC;
      }
      mx = fmaxf(mx, __shfl_xor(mx, 32));
      const float mn = fmaxf(m_[s], mx);
      const float alpha = __builtin_amdgcn_exp2f(m_[s] - mn);
      const bool resc = (mn != m_[s]);
      m_[s] = mn;
      float ls = 0.f;
      if (MODE == 1) {
#pragma unroll
        for (int kt2 = 0; kt2 < 2; ++kt2)
#pragma unroll
          for (int i = 0; i < 16; ++i) { float e = __builtin_amdgcn_exp2f(sc[kt2][i] - mn); sc[kt2][i] = e; ls += e; }
      } else {
        f32x2_t ls2 = {0.f, 0.f};
        const f32x2_t k2 = {KSC, KSC}, mn2 = {-mn, -mn};
#pragma unroll
        for (int kt2 = 0; kt2 < 2; ++kt2)
#pragma unroll
          for (int i = 0; i < 16; i += 2) {
            f32x2_t a = {sc[kt2][i], sc[kt2][i + 1]};
            a = __builtin_elementwise_fma(a, k2, mn2);
            f32x2_t e = {__builtin_amdgcn_exp2f(a[0]), __builtin_amdgcn_exp2f(a[1])};
            sc[kt2][i] = e[0]; sc[kt2][i + 1] = e[1];
            ls2 += e;
          }
        ls = ls2[0] + ls2[1];
      }
      l_[s] = l_[s] * alpha + ls;
      if (__any(resc)) {
#pragma unroll
        for (int dt = 0; dt < 2; ++dt)
#pragma unroll
          for (int i = 0; i < 16; ++i) o[s][dt][i] *= alpha;
      }
#pragma unroll
      for (int kt2 = 0; kt2 < 2; ++kt2)
#pragma unroll
        for (int st = 0; st < 2; ++st) {
          u32x4 pk;
#pragma unroll
          for (int j = 0; j < 4; ++j) pk[j] = pack2(sc[kt2][8 * st + 2 * j], sc[kt2][8 * st + 2 * j + 1]);
          bf16x8 pf = __builtin_bit_cast(bf16x8, pk);
          const int koff = kt2 * 32 + 16 * st + 4 * h;
#pragma unroll
          for (int dt = 0; dt < 2; ++dt) {
            u32x2 lo = *(const u32x2*)(sV + (dt * 32 + r) * 72 + koff);
            u32x2 hi = *(const u32x2*)(sV + (dt * 32 + r) * 72 + koff + 8);
            u32x4 vv; vv[0] = lo[0]; vv[1] = lo[1]; vv[2] = hi[0]; vv[3] = hi[1];
            o[s][dt] = MFMA32(__builtin_bit_cast(bf16x8, vv), pf, o[s][dt]);
          }
        }
    }
    __syncthreads();
  }
  float inv[NS];
#pragma unroll
  for (int s = 0; s < NS; ++s) { float lt = l_[s] + __shfl_xor(l_[s], 32); inv[s] = 1.f / lt; }
  if (!DIFF) {
#pragma unroll
    for (int dt = 0; dt < 2; ++dt)
#pragma unroll
      for (int i = 0; i < 16; ++i) sO[r * 72 + dt * 32 + crow(i, h)] = (u16)f2bf(o[0][dt][i] * inv[0]);
  } else {
    const float lam_init = 0.8f - 0.6f * __expf(-0.3f * (float)l);
    const float* dl = p.in[20] + l * 128;
    float s01 = 0.f, s23 = 0.f;
    for (int i = 0; i < 32; ++i) { s01 += dl[i] * dl[32 + i]; s23 += dl[64 + i] * dl[96 + i]; }
    const float lam = __expf(s01) - __expf(s23) + lam_init;
    const float* sg = p.in[21] + l * 64;
    float ss = 0.f;
#pragma unroll
    for (int dt = 0; dt < 2; ++dt)
#pragma unroll
      for (int i = 0; i < 16; ++i) { float v = o[0][dt][i] * inv[0] - lam * o[NS - 1][dt][i] * inv[NS - 1]; o[0][dt][i] = v; ss += v * v; }
    ss += __shfl_xor(ss, 32);
    const float rs = rsqrtf(ss * (1.f / 64.f) + EPS) * (1.f - lam_init);
#pragma unroll
    for (int dt = 0; dt < 2; ++dt)
#pragma unroll
      for (int i = 0; i < 16; ++i) { int d = dt * 32 + crow(i, h); sO[r * 72 + d] = (u16)f2bf(o[0][dt][i] * rs * sg[d]); }
  }
  __syncthreads();
  {
    u16* mix = wsp<u16>(p, OFF_MIX);
    const int tok0 = path * TP + b * L + qpos0 + w * 32;
    const int colb = (DIFF ? 512 : 256) + hd * 64;
#pragma unroll
    for (int i = 0; i < 4; ++i) {
      int c = lane + 64 * i, q = c >> 3, dc = c & 7;
      u32x4 v = *(const u32x4*)(sO + q * 72 + dc * 8);
      *(u32x4*)(mix + (size_t)(tok0 + q) * 1024 + colb + dc * 8) = v;
    }
  }
  __syncthreads();
}

DI void conv_item(const Params& p, int l, int item, unsigned char* smem) {
  const int tid = tid_opaque(), lane = tid & 63, w = tid >> 6;
  float* y = (float*)smem;
  const int t0 = item * 32;
  int L, pos0, tseq0;
  if (t0 < TP) { L = 256; pos0 = t0 & 255; tseq0 = t0 - pos0; } else { L = 4096; pos0 = (t0 - TP) & 4095; tseq0 = t0 - pos0; }
  const u16* ca = wsp<u16>(p, OFF_CONVA);
  const u16* cgp = wsp<u16>(p, OFF_CONVG);
  const int c = tid;
  for (int j = 0; j < 62; ++j) {
    int pos = pos0 - 15 + j;
    float v = 0.f;
    if (pos >= 0 && pos < L) {
      size_t idx = (size_t)(tseq0 + pos) * 256 + c;
      v = bf1(ca[idx]) * sigmoid_f(bf1(cgp[idx]));
    }
    y[j * 256 + c] = v;
  }
  float wv[31];
  const float* cw = p.in[11] + (size_t)l * 31 * 256 + c;
#pragma unroll
  for (int k = 0; k < 31; ++k) wv[k] = cw[k * 256];
  const float bias = p.in[12][l * 256 + c];
  float acc[32];
  __syncthreads();
#pragma unroll
  for (int i = 0; i < 32; ++i) {
    float a = bias;
#pragma unroll
    for (int k = 0; k < 31; ++k) a += y[(i + k) * 256 + c] * wv[k];
    acc[i] = a;
  }
  __syncthreads();
#pragma unroll
  for (int i = 0; i < 32; ++i) y[i * 256 + c] = acc[i];
  __syncthreads();
  const float* lg = p.in[13] + l * 256;
  const float* lb = p.in[14] + l * 256;
  u16* mix = wsp<u16>(p, OFF_MIX);
#pragma nounroll
  for (int ii = 0; ii < 8; ++ii) {
    int i = w * 8 + ii;
    float v[4]; float s = 0.f;
#pragma unroll
    for (int q = 0; q < 4; ++q) { v[q] = y[i * 256 + lane + 64 * q]; s += v[q]; }
    s = wave_sum(s);
    float mu = s * (1.f / 256.f);
    float vs = 0.f;
#pragma unroll
    for (int q = 0; q < 4; ++q) { float d = v[q] - mu; vs += d * d; }
    vs = wave_sum(vs);
    float rs = rsqrtf(vs * (1.f / 256.f) + EPS);
#pragma unroll
    for (int q = 0; q < 4; ++q) {
      int cc = lane + 64 * q;
      float z = (v[q] - mu) * rs * lg[cc] + lb[cc];
      mix[(size_t)(t0 + i) * 1024 + cc] = (u16)f2bf(z * sigmoid_f(z));
    }
  }
  __syncthreads();
}

DI void gmlp_item(const Params& p, int l, int item, unsigned char* smem) {
  const int tid = tid_opaque(), lane = tid & 63, w = tid >> 6, r = lane & 31, h = lane >> 5;
  const int n = item >> 2, g = item & 3;
  const int t0 = n * 128;
  u16* vnT = (u16*)smem;
  float* smu = (float*)(smem + 17408);
  float* srs = smu + 128;
  const u16* gv = wsp<u16>(p, OFF_GV);
  const u16* gu = wsp<u16>(p, OFF_GU);
  if (tid < 128) {
    const u16* rowp = gv + (size_t)(t0 + tid) * 256;
    float s = 0.f;
    for (int q = 0; q < 32; ++q) {
      u32x4 v = *(const u32x4*)(rowp + q * 8);
#pragma unroll
      for (int j = 0; j < 4; ++j) s += bf_lo(v[j]) + bf_hi(v[j]);
    }
    float mu = s * (1.f / 256.f);
    float vs = 0.f;
    for (int q = 0; q < 32; ++q) {
      u32x4 v = *(const u32x4*)(rowp + q * 8);
#pragma unroll
      for (int j = 0; j < 4; ++j) { float a = bf_lo(v[j]) - mu, bq = bf_hi(v[j]) - mu; vs += a * a + bq * bq; }
    }
    smu[tid] = mu; srs[tid] = rsqrtf(vs * (1.f / 256.f) + EPS);
  }
  __syncthreads();
  {
    const int j = tid & 127, chalf = tid >> 7;
    const float mu = smu[j], rs = srs[j];
    const u16* rowp = gv + (size_t)(t0 + j) * 256 + g * 64 + chalf * 32;
    const float* lg = p.in[22] + l * 256 + g * 64 + chalf * 32;
    const float* lb = p.in[23] + l * 256 + g * 64 + chalf * 32;
#pragma unroll
    for (int q = 0; q < 4; ++q) {
      u32x4 v = *(const u32x4*)(rowp + q * 8);
#pragma unroll
      for (int jj = 0; jj < 4; ++jj) {
        int c0 = q * 8 + jj * 2;
        float a = (bf_lo(v[jj]) - mu) * rs * lg[c0] + lb[c0];
        float bq = (bf_hi(v[jj]) - mu) * rs * lg[c0 + 1] + lb[c0 + 1];
        vnT[(chalf * 32 + c0) * 136 + j] = (u16)f2bf(a);
        vnT[(chalf * 32 + c0 + 1) * 136 + j] = (u16)f2bf(bq);
      }
    }
  }
  __syncthreads();
  f32x16 acc[2];
#pragma unroll
  for (int nt = 0; nt < 2; ++nt)
#pragma unroll
    for (int i = 0; i < 16; ++i) acc[nt][i] = 0.f;
  const u16* wsg = wsp<u16>(p, OFF_GWS) + ((size_t)(l * 4 + g) * 128 + w * 32 + r) * 128;
#pragma unroll
  for (int ks = 0; ks < 8; ++ks) {
    bf16x8 a = *(const bf16x8*)(wsg + ks * 16 + 8 * h);
#pragma unroll
    for (int nt = 0; nt < 2; ++nt) {
      bf16x8 bq = *(const bf16x8*)(vnT + (nt * 32 + r) * 136 + ks * 16 + 8 * h);
      acc[nt] = MFMA32(a, bq, acc[nt]);
    }
  }
  const float* bs = p.in[25] + (size_t)(l * 4 + g) * 128;
  u16* mix = wsp<u16>(p, OFF_MIX);
#pragma unroll
  for (int nt = 0; nt < 2; ++nt)
#pragma unroll
    for (int i = 0; i < 16; ++i) {
      int ir = w * 32 + crow(i, h), cc = nt * 32 + r;
      float u = bf1(gu[(size_t)(t0 + ir) * 256 + g * 64 + cc]);
      mix[(size_t)(t0 + ir) * 1024 + 768 + g * 64 + cc] = (u16)f2bf(u * (acc[nt][i] + bs[ir]));
    }
  __syncthreads();
}

DI void phase_mix(const Params& p, int l, unsigned char* smem, int rep = 0) {
  int* ctr = wsp<int>(p, OFF_CTR) + l + 2 * rep;
  int* sitem = (int*)(smem + SMEM_BYTES - 16);
  while (true) {
    __syncthreads();
    if (threadIdx.x == 0) *sitem = atomicAdd(ctr, 1);
    __syncthreads();
    const int item = *sitem;
    __syncthreads();
    if (item >= (l == 0 ? 3104 : 2560)) break;
    if (item < 256) { if (MIXMASK & 1) attn_item<3>(p, l, item, smem); }
    else if (item < 512) { if (MIXMASK & 2) attn_item<1>(p, l, item - 256, smem); }
    else if (item < 768) { if (MIXMASK & 4) attn_item<2>(p, l, item - 512, smem); }
    else if (item < 1024) { if (MIXMASK & 8) attn_item<0>(p, l, item - 768, smem); }
    else if (item < 1536) { if (MIXMASK & 16) gmlp_item(p, l, item - 1024, smem); }
    else if (item < 2048) { if (MIXMASK & 32) conv_item(p, l, item - 1536, smem); }
    else if (item < 2560) {
      const int q = item - 2048, tab = q >> 8, row0 = l * 16384 + (q & 255) * 64;
      quant_rows64(p.in[tab == 0 ? 29 : 30], p.ws + (tab == 0 ? OFF_PU : OFF_PV), wsp<float>(p, tab == 0 ? OFF_SU : OFF_SV), row0, tab == 0);
    } else if (item < 2816) {
      fusedwq_item(p, item - 2560, smem);
    } else {
#pragma nounroll
      for (int j = 0; j < 4; ++j) {
        const int tt = (item - 2816) * 4 + j;
        const int ti = tt < 512 ? 1280 + tt : 640 + (tt - 512);
        transpose_item(p, ti, (float*)smem);
      }
    }
  }
}

DI void phase_outproj(const Params& p, int l, unsigned char* smem) {
  const int tid = tid_opaque(), lane = tid & 63, w = tid >> 6, r = lane & 31, h = lane >> 5;
  const int wm = w >> 1, wn = w & 1;
  const u16* A = wsp<u16>(p, OFF_MIX);
  const u16* Bt = wsp<u16>(p, OFF_WTOUT) + (size_t)l * 1024 * 1024;
  float* xmid = wsp<float>(p, OFF_XMID);
  GemmPre pre;
  gemm_prefetch(tid, A, Bt, 1024, ((int)blockIdx.x >> 3) * 128, ((int)blockIdx.x & 7) * 128, pre);
  for (int tile = blockIdx.x; tile < 128 * 8; tile += gridDim.x) {
    int mt_ = tile >> 3, nt_ = tile & 7;
    const int m0 = mt_ * 128, n0 = nt_ * 128;
    f32x16 acc[2][2];
    gemm_main<true>(tid, A, Bt, 1024, m0, n0, (u16*)smem, acc, 0, 0, &pre);
    { const int nx = tile + gridDim.x; if (nx < 128 * 8) gemm_prefetch(tid, A, Bt, 1024, (nx >> 3) * 128, (nx & 7) * 128, pre); }
    const float* g1 = wsp<float>(p, OFF_MOD) + (size_t)(l * 3 + mod_row(m0)) * 6144 + 2048;
    acc_to_lds<132>(tid, acc, (float*)smem);
    __syncthreads();
    {
      const float* Ct = (const float*)smem;
      const int c = (tid & 31) * 4;
      const float4 gv = *(const float4*)(g1 + n0 + c);
#pragma unroll
      for (int it = 0; it < 16; ++it) {
        const int row = it * 8 + (tid >> 5), m = m0 + row;
        const float4 cv = *(const float4*)(Ct + row * 132 + c);
        const float4 xv = *(const float4*)(xin_row(p, l, m) + n0 + c);
        *(float4*)(xmid + (size_t)m * 1024 + n0 + c) = make_float4(xv.x + gv.x * cv.x, xv.y + gv.y * cv.y, xv.z + gv.z * cv.z, xv.w + gv.w * cv.w);
      }
    }
  }
}

DI void ins16(float (&Lst)[16], float key) {
#pragma unroll
  for (int j = 15; j >= 1; --j) Lst[j] = __builtin_amdgcn_fmed3f(key, Lst[j - 1], Lst[j]);
  Lst[0] = fmaxf(key, Lst[0]);
}

DI void phase_peerq(const Params& p, int l, unsigned char* smem) {
  const int tid = tid_opaque(), lane = tid & 63, w = tid >> 6, r = lane & 31, h = lane >> 5;
  const int wm = w >> 1, wn = w & 1;
  const u16* A = wsp<u16>(p, OFF_H);
  const u16* Bt = wsp<u16>(p, OFF_WTQ) + (size_t)l * 2048 * 1024;
  u16* sQ = (u16*)smem;
  u16* sS = sQ + 128 * 136;
  float* Ct = (float*)smem;
  u32* tmpl = (u32*)(smem + 66048);
  float* ltmp = wsp<float>(p, OFF_LTMP) + (size_t)blockIdx.x * 4096;
  GemmPre pre;
  gemm_prefetch(tid, A, Bt, 1024, ((int)blockIdx.x >> 3) * 128, (((int)blockIdx.x & 7) * 2) * 128, pre);
  for (int item = blockIdx.x; item < 1024; item += gridDim.x) {
    const int m0 = (item >> 3) * 128, hd = item & 7;
#pragma nounroll
    for (int pp = 0; pp < 2; ++pp) {
      f32x16 acc[2][2];
      gemm_main<true>(tid, A, Bt, 1024, m0, (hd * 2 + pp) * 128, (u16*)smem, acc, 0, 0, &pre);
      {
        const int nitem = pp == 0 ? item : item + (int)gridDim.x, npp = pp ^ 1;
        if (nitem < 1024) gemm_prefetch(tid, A, Bt, 1024, (nitem >> 3) * 128, ((nitem & 7) * 2 + npp) * 128, pre);
      }
      acc_to_lds(tid, acc, Ct);
      __syncthreads();
      const int row = tid & 127, half = tid >> 7;
      float Lc[16];
#pragma unroll
      for (int j = 0; j < 16; ++j) Lc[j] = -INFINITY;
#pragma nounroll
      for (int j0 = 0; j0 < 64; j0 += 8) {
#pragma unroll
        for (int jj = 0; jj < 8; ++jj) {
          int j = j0 + jj;
          float v = Ct[row * 129 + half * 64 + j];
          float key = __uint_as_float((__float_as_uint(v) & 0xffffff80u) | (u32)(half * 64 + j));
          ins16(Lc, key);
        }
      }
      if (half == 1) {
#pragma unroll
        for (int j = 0; j < 16; ++j) tmpl[row * 16 + j] = __float_as_uint(Lc[j]);
      }
      __syncthreads();
      if (half == 0) {
#pragma unroll
        for (int j = 0; j < 16; ++j) ins16(Lc, __uint_as_float(tmpl[row * 16 + j]));
#pragma unroll
        for (int j = 0; j < 16; j += 4) *(float4*)(ltmp + (pp * 128 + row) * 16 + j) = make_float4(Lc[j], Lc[j + 1], Lc[j + 2], Lc[j + 3]);
      }
    }
    __syncthreads();
    u32* lists = (u32*)smem;
    if (tid < 128) {
      const int row = tid;
      float La[16], Lb[16];
#pragma unroll
      for (int j = 0; j < 16; j += 4) { float4 q = *(const float4*)(ltmp + row * 16 + j); La[j] = q.x; La[j + 1] = q.y; La[j + 2] = q.z; La[j + 3] = q.w; }
#pragma unroll
      for (int j = 0; j < 16; j += 4) { float4 q = *(const float4*)(ltmp + (128 + row) * 16 + j); Lb[j] = q.x; Lb[j + 1] = q.y; Lb[j + 2] = q.z; Lb[j + 3] = q.w; }
#pragma unroll
      for (int j = 0; j < 16; ++j) { lists[(row * 2 + 0) * 16 + j] = __float_as_uint(La[j]); lists[(row * 2 + 1) * 16 + j] = __float_as_uint(Lb[j]); }
      float Tl[16];
#pragma unroll
      for (int j = 0; j < 16; ++j) Tl[j] = -INFINITY;
#pragma unroll
      for (int i = 0; i < 16; ++i) {
        const float va = __uint_as_float(__float_as_uint(La[i]) & 0xffffff80u);
#pragma unroll
        for (int j = 0; j < 16; ++j) {
          if ((i + 1) * (j + 1) <= 16) {
            float vb = __uint_as_float(__float_as_uint(Lb[j]) & 0xffffff80u);
            float sum = va + vb;
            float key = __uint_as_float((__float_as_uint(sum) & 0xffffff00u) | (u32)(i * 16 + j));
            ins16(Tl, key);
          }
        }
      }
      float ev[16]; int ei[16];
      float mx = 0.f, den = 0.f;
#pragma unroll
      for (int k = 0; k < 16; ++k) {
        u32 code = __float_as_uint(Tl[k]) & 255u;
        u32 ka = lists[(row * 2 + 0) * 16 + (code >> 4)];
        u32 kb = lists[(row * 2 + 1) * 16 + (code & 15u)];
        float s = __uint_as_float(ka & 0xffffff80u) + __uint_as_float(kb & 0xffffff80u);
        if (k == 0) mx = s;
        float e = __expf(s - mx);
        ev[k] = e; den += e;
        ei[k] = (int)((ka & 127u) * 128u + (kb & 127u));
      }
      const float rden = 1.f / den;
      int* eo = wsp<int>(p, OFF_EIDX) + ((size_t)(m0 + row) * 8 + hd) * 16;
      float* go = wsp<float>(p, OFF_GATE) + ((size_t)(m0 + row) * 8 + hd) * 16;
#pragma unroll
      for (int k = 0; k < 16; k += 4) {
        *(int4*)(eo + k) = make_int4(ei[k], ei[k + 1], ei[k + 2], ei[k + 3]);
        *(float4*)(go + k) = make_float4(ev[k] * rden, ev[k + 1] * rden, ev[k + 2] * rden, ev[k + 3] * rden);
      }
    }
  }
}

typedef float f32x2 __attribute__((ext_vector_type(2)));
typedef _Float16 h2_t __attribute__((ext_vector_type(2)));
DI float dot16f4h(const u32x2& a, const h2_t (&hh)[8]) {
  float s = 0.f;
  s = __builtin_amdgcn_fdot2(__builtin_amdgcn_cvt_scalef32_pk_f16_fp4(a[0], 1.0f, 0), hh[0], s, false);
  s = __builtin_amdgcn_fdot2(__builtin_amdgcn_cvt_scalef32_pk_f16_fp4(a[0], 1.0f, 1), hh[1], s, false);
  s = __builtin_amdgcn_fdot2(__builtin_amdgcn_cvt_scalef32_pk_f16_fp4(a[0], 1.0f, 2), hh[2], s, false);
  s = __builtin_amdgcn_fdot2(__builtin_amdgcn_cvt_scalef32_pk_f16_fp4(a[0], 1.0f, 3), hh[3], s, false);
  s = __builtin_amdgcn_fdot2(__builtin_amdgcn_cvt_scalef32_pk_f16_fp4(a[1], 1.0f, 0), hh[4], s, false);
  s = __builtin_amdgcn_fdot2(__builtin_amdgcn_cvt_scalef32_pk_f16_fp4(a[1], 1.0f, 1), hh[5], s, false);
  s = __builtin_amdgcn_fdot2(__builtin_amdgcn_cvt_scalef32_pk_f16_fp4(a[1], 1.0f, 2), hh[6], s, false);
  s = __builtin_amdgcn_fdot2(__builtin_amdgcn_cvt_scalef32_pk_f16_fp4(a[1], 1.0f, 3), hh[7], s, false);
  return s;
}
DI float dot16f4(const u32x2& a, const float (&hf)[16]) {
  f32x2 s = {0.f, 0.f};
#pragma unroll
  for (int q = 0; q < 2; ++q) {
#pragma unroll
    for (int b = 0; b < 4; ++b) {
      f32x2 e;
      if (b == 0) e = __builtin_amdgcn_cvt_scalef32_pk_f32_fp4(a[q], 1.0f, 0);
      else if (b == 1) e = __builtin_amdgcn_cvt_scalef32_pk_f32_fp4(a[q], 1.0f, 1);
      else if (b == 2) e = __builtin_amdgcn_cvt_scalef32_pk_f32_fp4(a[q], 1.0f, 2);
      else e = __builtin_amdgcn_cvt_scalef32_pk_f32_fp4(a[q], 1.0f, 3);
      f32x2 hv = {hf[8 * q + 2 * b], hf[8 * q + 2 * b + 1]};
      s = __builtin_elementwise_fma(e, hv, s);
    }
  }
  return s[0] + s[1];
}

DI void phase_peer(const Params& p, int l, unsigned char* smem) {
  const int tid = tid_opaque(), lane = tid & 63, w = tid >> 6;
  const int gw = blockIdx.x * 4 + w, nw = gridDim.x * 4;
  const unsigned char* PU = p.ws + OFF_PU + (size_t)l * 16384 * 512;
  const unsigned char* PV = p.ws + OFF_PV + (size_t)l * 16384 * 512;
  const float* SU = wsp<float>(p, OFF_SU) + l * 16384;
  const float* SV = wsp<float>(p, OFF_SV) + l * 16384;
  u16* H = wsp<u16>(p, OFF_H);
  const int* EI = wsp<int>(p, OFF_EIDX);
  const float* GT = wsp<float>(p, OFF_GATE);
  const float* xmid = wsp<float>(p, OFF_XMID);
  float* wbuf = (float*)smem + w * 1024;
  const __amdgpu_buffer_rsrc_t rsU = __builtin_amdgcn_make_buffer_rsrc((void*)PU, (short)0, 16384 * 512, 0x00020000);
  const __amdgpu_buffer_rsrc_t rsV = __builtin_amdgcn_make_buffer_rsrc((void*)PV, (short)0, 16384 * 512, 0x00020000);
  const unsigned loff8 = (unsigned)lane * 8u;
  const bool b0 = lane & 1, b1 = lane & 2, b2 = lane & 4, b3 = lane & 8, b4 = lane & 16;
  const int l31 = lane & 31;
#pragma nounroll
  for (int tb = gw; tb < T; tb += nw * 8) {
#pragma nounroll
    for (int i = 0; i < 8; ++i) {
      const int t = tb + i * nw;
      if (t >= T) break;
      int hiW[2], loW[2];
      float inv_hs;
      {
        u32x4 ha = *(const u32x4*)(H + (size_t)t * 1024 + lane * 16);
        u32x4 hb = *(const u32x4*)(H + (size_t)t * 1024 + lane * 16 + 8);
        float hv[16];
#pragma unroll
        for (int q = 0; q < 4; ++q) { hv[2 * q] = bf_lo(ha[q]); hv[2 * q + 1] = bf_hi(ha[q]); hv[8 + 2 * q] = bf_lo(hb[q]); hv[8 + 2 * q + 1] = bf_hi(hb[q]); }
        float hm = 0.f;
#pragma unroll
        for (int j = 0; j < 16; ++j) hm = fmaxf(hm, fabsf(hv[j]));
#pragma unroll
        for (int d = 32; d >= 1; d >>= 1) hm = fmaxf(hm, __shfl_xor(hm, d));
        const float hs = hm > 0.f ? 119.f / hm : 0.f;
        inv_hs = hm * (1.f / 119.f);
#pragma unroll
        for (int w2 = 0; w2 < 2; ++w2) {
          u32 ph = 0u, pl = 0u;
#pragma unroll
          for (int i = 0; i < 8; ++i) {
            const int hq = (int)__builtin_rintf(hv[8 * w2 + i] * hs);
            const int hi = (hq + 8) >> 4, lo = hq - 16 * hi;
            ph |= ((u32)hi & 0xFu) << (4 * i); pl |= ((u32)lo & 0xFu) << (4 * i);
          }
          hiW[w2] = (int)ph; loW[w2] = (int)pl;
        }
      }
      int e8[8];
#pragma unroll
      for (int hd = 0; hd < 8; ++hd) e8[hd] = EI[(size_t)t * 128 + hd * 16 + (lane & 15)];
      u32x2 ruA[16], ruB[16];
#define P1_LOAD(R, HD) { _Pragma("unroll") for (int k = 0; k < 16; ++k) { const int ek = __builtin_amdgcn_readlane(e8[HD], k); R[k] = __builtin_bit_cast(u32x2, __builtin_amdgcn_raw_buffer_load_b64(rsU, (int)loff8, ek * 512, 0)); } }
#define P1_COMP(R, HD) { \
        const float g = GT[(size_t)t * 128 + (HD) * 16 + (lane & 15)]; \
        const float su = SU[e8[HD]], sv = SV[e8[HD]]; \
        float part[16]; \
        _Pragma("unroll") for (int k = 0; k < 16; ++k) { \
          int dh = __builtin_amdgcn_sdot8((int)R[k][0], hiW[0], 0, false); dh = __builtin_amdgcn_sdot8((int)R[k][1], hiW[1], dh, false); \
          int dl = __builtin_amdgcn_sdot8((int)R[k][0], loW[0], 0, false); dl = __builtin_amdgcn_sdot8((int)R[k][1], loW[1], dl, false); \
          part[k] = (float)(16 * dh + dl); } \
        float q8[8], q4[4], q2[2], q1; \
        _Pragma("unroll") for (int j = 0; j < 8; ++j) { float keep = b0 ? part[2 * j + 1] : part[2 * j]; float send = b0 ? part[2 * j] : part[2 * j + 1]; q8[j] = keep + swz_xor(send, 1); } \
        _Pragma("unroll") for (int j = 0; j < 4; ++j) { float keep = b1 ? q8[2 * j + 1] : q8[2 * j]; float send = b1 ? q8[2 * j] : q8[2 * j + 1]; q4[j] = keep + swz_xor(send, 2); } \
        _Pragma("unroll") for (int j = 0; j < 2; ++j) { float keep = b2 ? q4[2 * j + 1] : q4[2 * j]; float send = b2 ? q4[2 * j] : q4[2 * j + 1]; q2[j] = keep + swz_xor(send, 4); } \
        { float keep = b3 ? q2[1] : q2[0]; float send = b3 ? q2[0] : q2[1]; q1 = keep + swz_xor(send, 8); } \
        q1 += swz_xor(q1, 16); \
        q1 += __shfl_xor(q1, 32); \
        const float wgt = gelu_f(q1 * su * inv_hs) * g * sv; \
        if (lane < 16) wbuf[i * 128 + (HD) * 16 + lane] = wgt; }
      P1_LOAD(ruA, 0)
#pragma unroll
      for (int hd = 0; hd < 8; hd += 2) {
        P1_LOAD(ruB, hd + 1)
        P1_COMP(ruA, hd)
        if (hd + 2 < 8) P1_LOAD(ruA, hd + 2)
        P1_COMP(ruB, hd + 1)
      }
#undef P1_LOAD
#undef P1_COMP
    }
#pragma nounroll
    for (int i = 0; i < 8; ++i) {
      const int t = tb + i * nw;
      if (t >= T) break;
      float acc[16];
#pragma unroll
      for (int j = 0; j < 16; ++j) acc[j] = 0.f;
      int e8[8];
#pragma unroll
      for (int hd = 0; hd < 8; ++hd) e8[hd] = EI[(size_t)t * 128 + hd * 16 + (lane & 15)];
      u32x2 rvA[16];
#define P2_LOAD(R, HD) { _Pragma("unroll") for (int k = 0; k < 16; ++k) { const int ek = __builtin_amdgcn_readlane(e8[HD], k); R[k] = __builtin_bit_cast(u32x2, __builtin_amdgcn_raw_buffer_load_b64(rsV, (int)loff8, ek * 512, 0)); } }
#define P2_COMP(R, HD) { \
        const float wgt = wbuf[i * 128 + (HD) * 16 + (lane & 15)]; \
        _Pragma("unroll") for (int k = 0; k < 16; ++k) { \
          const float wk = __uint_as_float(__builtin_amdgcn_readlane(__float_as_uint(wgt), k)); \
          _Pragma("unroll") for (int q = 0; q < 2; ++q) { \
            f32x2 e0 = __builtin_amdgcn_cvt_scalef32_pk_f32_fp4(R[k][q], 1.0f, 0); \
            f32x2 e1 = __builtin_amdgcn_cvt_scalef32_pk_f32_fp4(R[k][q], 1.0f, 1); \
            f32x2 e2 = __builtin_amdgcn_cvt_scalef32_pk_f32_fp4(R[k][q], 1.0f, 2); \
            f32x2 e3 = __builtin_amdgcn_cvt_scalef32_pk_f32_fp4(R[k][q], 1.0f, 3); \
            acc[8 * q] += wk * e0[0]; acc[8 * q + 1] += wk * e0[1]; acc[8 * q + 2] += wk * e1[0]; acc[8 * q + 3] += wk * e1[1]; \
            acc[8 * q + 4] += wk * e2[0]; acc[8 * q + 5] += wk * e2[1]; acc[8 * q + 6] += wk * e3[0]; acc[8 * q + 7] += wk * e3[1]; } } }
#pragma unroll
      for (int hd = 0; hd < 8; ++hd) {
        P2_LOAD(rvA, hd)
        P2_COMP(rvA, hd)
      }
#undef P2_LOAD
#undef P2_COMP
      const float* g2 = wsp<float>(p, OFF_MOD) + (size_t)(l * 3 + mod_row(t)) * 6144 + 5120;
      float* yo = p.out + (size_t)t * 1024;
      const float* xm = xmid + (size_t)t * 1024;
      float ss = 0.f;
#pragma unroll
      for (int q = 0; q < 4; ++q) {
        int n = lane * 16 + q * 4;
        float4 x0 = *(const float4*)(xm + n);
        float4 ga = *(const float4*)(g2 + n);
        acc[4 * q] = x0.x + ga.x * acc[4 * q]; acc[4 * q + 1] = x0.y + ga.y * acc[4 * q + 1];
        acc[4 * q + 2] = x0.z + ga.z * acc[4 * q + 2]; acc[4 * q + 3] = x0.w + ga.w * acc[4 * q + 3];
        *(float4*)(yo + n) = make_float4(acc[4 * q], acc[4 * q + 1], acc[4 * q + 2], acc[4 * q + 3]);
        ss += acc[4 * q] * acc[4 * q] + acc[4 * q + 1] * acc[4 * q + 1] + acc[4 * q + 2] * acc[4 * q + 2] + acc[4 * q + 3] * acc[4 * q + 3];
      }
      if (l == 0) {
        ss = wave_sum(ss);
        const float rs = rsqrtf(ss * (1.f / 1024.f) + EPS);
        const float* gam = p.in[8] + 1024;
        const float* md = wsp<float>(p, OFF_MOD) + (size_t)(3 + mod_row(t)) * 6144;
        float hv[16];
#pragma unroll
        for (int q = 0; q < 4; ++q) {
          int n = lane * 16 + q * 4;
          float4 gg = *(const float4*)(gam + n), sh = *(const float4*)(md + n), sc = *(const float4*)(md + 1024 + n);
          hv[4 * q] = acc[4 * q] * rs * gg.x * (1.f + sc.x) + sh.x; hv[4 * q + 1] = acc[4 * q + 1] * rs * gg.y * (1.f + sc.y) + sh.y;
          hv[4 * q + 2] = acc[4 * q + 2] * rs * gg.z * (1.f + sc.z) + sh.z; hv[4 * q + 3] = acc[4 * q + 3] * rs * gg.w * (1.f + sc.w) + sh.w;
        }
        st8(H + (size_t)t * 1024 + lane * 16, hv);
        st8(H + (size_t)t * 1024 + lane * 16 + 8, hv + 8);
      }
    }
  }
}

#define XB_TMO      128
#define XB_XCNT(j)  (256  + 64 * (j))
#define XB_XSUB(j)  (1280 + 64 * (j))
#define XB_XGEN(j)  (2304 + 64 * (j))
#define XB_TOP      3328
#define XB_TOPGEN   3392
#define XCD_BAR_WORDS 3456
#define XB_SPIN_CAP (1u << 20)
#define LAS __attribute__((address_space(3)))
DI unsigned xb_ld(unsigned* p) { return __hip_atomic_load(p, __ATOMIC_RELAXED, __HIP_MEMORY_SCOPE_AGENT); }
DI unsigned xb_add(unsigned* p, unsigned v) { return __hip_atomic_fetch_add(p, v, __ATOMIC_RELAXED, __HIP_MEMORY_SCOPE_AGENT); }
DI unsigned xb_xcc_id() { return (unsigned)__builtin_amdgcn_s_getreg((3 << 11) | 20) & 0xFu; }
#define XB_SPIN(cond, bar) do { unsigned _sp = 0; while (cond) { __builtin_amdgcn_s_sleep(1); \
    if ((++_sp & 255u) == 0u) { if (xb_ld(&(bar)[XB_TMO])) break; if (_sp > XB_SPIN_CAP) { atomicAdd(&(bar)[XB_TMO], 1u); break; } } } } while (0)
struct XcdBarrier { unsigned* bar; unsigned x; volatile LAS unsigned* st; };
DI XcdBarrier xcd_barrier_post(unsigned* bar, volatile LAS unsigned* st) {
  XcdBarrier b; b.bar = bar; b.x = xb_xcc_id(); b.st = st;
  if (threadIdx.x == 0) (void)xb_add(&bar[XB_XCNT(b.x)], 1u);
  return b;
}
DI void xcd_barrier_complete(unsigned* bar, unsigned x, unsigned& nloc, unsigned& nx) {
  const unsigned G = gridDim.x * gridDim.y * gridDim.z;
  unsigned sum, cnt, mine, sp = 0u;
  for (;;) {
    sum = 0u; cnt = 0u; mine = 0u;
#pragma unroll
    for (unsigned j = 0; j < 16; ++j) { const unsigned c = xb_ld(&bar[XB_XCNT(j)]); sum += c; cnt += (c > 0u) ? 1u : 0u; mine = (j == x) ? c : mine; }
    if (sum == G) break;
    __builtin_amdgcn_s_sleep(1);
    if ((++sp & 255u) == 0u) { if (xb_ld(&bar[XB_TMO])) break; if (sp > XB_SPIN_CAP) { atomicAdd(&bar[XB_TMO], 1u); break; } }
  }
  nloc = mine > 0u ? mine : 1u; nx = cnt > 0u ? cnt : 1u;
}
DI void xcd_barrier(const XcdBarrier& b) {
  asm volatile("s_waitcnt vmcnt(0)" ::: "memory");
  __syncthreads();
  if (threadIdx.x == 0) {
    unsigned* bar = b.bar;
    __builtin_amdgcn_s_waitcnt(0);
    unsigned nloc = b.st[0], nx = b.st[1];
    if (nloc == 0u) { xcd_barrier_complete(bar, b.x, nloc, nx); b.st[0] = nloc; b.st[1] = nx; }
    const unsigned old = xb_add(&bar[XB_XSUB(b.x)], 1u);
    const unsigned gen = old / nloc;
    if (old + 1u == (gen + 1u) * nloc) {
      __builtin_amdgcn_fence(__ATOMIC_RELEASE, "agent");
      asm volatile("s_waitcnt vmcnt(0)" ::: "memory");
      const unsigned og = xb_add(&bar[XB_TOP], 1u);
      const unsigned tg = og / nx;
      if (og + 1u == (tg + 1u) * nx) xb_add(&bar[XB_TOPGEN], 1u);
      else XB_SPIN(xb_ld(&bar[XB_TOPGEN]) == tg, bar);
      __builtin_amdgcn_fence(__ATOMIC_ACQUIRE, "agent");
      xb_add(&bar[XB_XGEN(b.x)], 1u);
      asm volatile("s_waitcnt vmcnt(0)" ::: "memory");
    } else {
      XB_SPIN(xb_ld(&bar[XB_XGEN(b.x)]) == gen, bar);
      __builtin_amdgcn_fence(__ATOMIC_ACQUIRE, "agent");
      asm volatile("s_waitcnt vmcnt(0)" ::: "memory");
    }
  }
  __syncthreads();
}

__global__ void __launch_bounds__(256, 2) mega(Params p, int ph_lo, int ph_hi) {
  __shared__ __attribute__((aligned(16))) unsigned char smem[SMEM_BYTES];
  __shared__ uint4 xb_words;
  cg::grid_group grid = cg::this_grid();
  if (threadIdx.x == 0) xb_words = make_uint4(0u, 0u, 0u, 0u);
  __syncthreads();
  XcdBarrier xb = xcd_barrier_post((unsigned*)(p.ws + OFF_BAR), (volatile LAS unsigned*)&xb_words);
  for (int ph = ph_lo; ph < ph_hi; ++ph) {
    if (ph == 8) continue;
    if (ph == 0) phase0(p, smem);
    else {
      const int l = (ph - 1) / 7, s = (ph - 1) % 7;
      if (s == 0) phase_norm(p, l, 0);
      else if (s == 1) phase_proj(p, l, smem);
      else if (s == 2) phase_mix(p, l, smem);
      else if (s == 3) phase_outproj(p, l, smem);
      else if (s == 4) phase_norm(p, l, 1);
      else if (s == 5) phase_peerq(p, l, smem);
      else phase_peer(p, l, smem);
      if (DUP_PHASE == s) {
        xcd_barrier(xb);
        if (s == 0) phase_norm(p, l, 0);
        else if (s == 1) phase_proj(p, l, smem);
        else if (s == 2) phase_mix(p, l, smem, 1);
        else if (s == 3) phase_outproj(p, l, smem);
        else if (s == 4) phase_norm(p, l, 1);
        else if (s == 5) phase_peerq(p, l, smem);
        else phase_peer(p, l, smem);
      }
    }
    if (ph + 1 < ph_hi) { if (ph_hi < 0) grid.sync(); xcd_barrier(xb); for (int q = 0; q < EXTRA_SYNCS; ++q) xcd_barrier(xb); }
  }
}

extern "C" void kernel_launch(void* const* d_in, const int* in_sizes, int n_in, void* d_out, int out_size, void* d_ws, size_t ws_size,
                              hipStream_t stream) {
  static int grid_blocks = 0;
  if (!grid_blocks) {
    int dev = 0, cus = 0, per_cu = 0;
    hipGetDevice(&dev);
    hipDeviceGetAttribute(&cus, hipDeviceAttributeMultiprocessorCount, dev);
    hipOccupancyMaxActiveBlocksPerMultiprocessor(&per_cu, mega, 256, 0);
    if (per_cu < 1) per_cu = 1;
    if (per_cu > 2) per_cu = 2;
    grid_blocks = cus * per_cu;
    if (grid_blocks > 1024) grid_blocks = 1024;
    if (ws_size < WS_END) fprintf(stderr, "kernel_launch: workspace too small (%zu < %zu)\n", ws_size, (size_t)WS_END);
  }
  Params p{};
  for (int i = 0; i < 31; ++i) p.in[i] = (const float*)d_in[i];
  p.out = (float*)d_out;
  p.ws = (unsigned char*)d_ws;
  (void)hipMemsetAsync((unsigned char*)d_ws + OFF_BAR, 0, XCD_BAR_WORDS * 4, stream);
#if COOP
  int lo = 0, hi = PH_END;
  void* args[] = {&p, &lo, &hi};
  hipError_t e = hipLaunchCooperativeKernel((void*)mega, dim3(grid_blocks), dim3(256), args, 0, stream);
  if (e != hipSuccess) fprintf(stderr, "cooperative launch failed: %s (grid %d)\n", hipGetErrorString(e), grid_blocks);
#else
  for (int ph = 0; ph < PH_END; ++ph) hipLaunchKernelGGL(mega, dim3(grid_blocks), dim3(256), 0, stream, p, ph, ph + 1);
#endif
}
```
